# Optimizing an MI355X kernel written in HIP

```python
import jax, jax.numpy as jnp
from jax import lax
import numpy as np

D_MODEL = 1024
BATCH = 8
SEQ = 4096
DEPTH = 1

CHUNK = 128
GM_WIDTH = D_MODEL
GM_GROUPS = 8
GM_GROUP_DIM = GM_WIDTH // GM_GROUPS
N_Q_HEADS = 16
N_KV_HEADS = 4
HEAD_DIM = 64
Q_REP = N_Q_HEADS // N_KV_HEADS
Q_WIDTH = N_Q_HEADS * HEAD_DIM
KV_WIDTH = N_KV_HEADS * HEAD_DIM
WINDOW = 128
BLOCK = WINDOW
N_BRANCH = 2
D_FF = 4 * D_MODEL
IN_WIDTH = 2 * GM_WIDTH + Q_WIDTH + 2 * KV_WIDTH + N_BRANCH * D_MODEL
N_MOD = 6
EPS = 1e-6

kernel_name = "hybrid_gmlp_swa_sink_adaln_block"


def rmsnorm(x, g):
    xf = x.astype(jnp.float32)
    y = xf * lax.rsqrt(jnp.mean(xf * xf, axis=-1, keepdims=True) + EPS)
    return (y * g.astype(jnp.float32)).astype(x.dtype)


def layernorm(x, g, b):
    xf = x.astype(jnp.float32)
    mu = jnp.mean(xf, axis=-1, keepdims=True)
    xc = xf - mu
    var = jnp.mean(xc * xc, axis=-1, keepdims=True)
    y = xc * lax.rsqrt(var + EPS) * g.astype(jnp.float32) + b.astype(jnp.float32)
    return y.astype(x.dtype)


def gmlp_spatial_gating(u, v, ln_g, ln_b, ws, bs):
    B, S, _ = v.shape
    n_chunks = S // CHUNK
    u = jax.nn.gelu(u)
    v = layernorm(jax.nn.gelu(v), ln_g, ln_b)
    vc = v.reshape(B, n_chunks, CHUNK, GM_GROUPS, GM_GROUP_DIM)
    causal = jnp.tril(jnp.ones((CHUNK, CHUNK), dtype=bool))
    ws_c = jnp.where(causal[None], ws, jnp.zeros_like(ws))
    s = jnp.einsum("gts,bnsgc->bntgc", ws_c, vc) + bs.T[None, None, :, :, None]
    return u * s.reshape(B, S, GM_WIDTH)


def sliding_window_sink_attention(q, k, v, sinks):
    B, S, _ = q.shape
    nb = S // BLOCK
    qb = q.reshape(B, nb, BLOCK, N_KV_HEADS, Q_REP, HEAD_DIM)
    kc = k.reshape(B, nb, BLOCK, N_KV_HEADS, HEAD_DIM)
    vc = v.reshape(B, nb, BLOCK, N_KV_HEADS, HEAD_DIM)
    shift = lambda t: jnp.concatenate([jnp.zeros_like(t[:, :1]), t[:, :-1]], axis=1)
    kb = jnp.concatenate([shift(kc), kc], axis=2)
    vb = jnp.concatenate([shift(vc), vc], axis=2)
    scores = jnp.einsum("bnqgrd,bnkgd->bngrqk", qb, kb).astype(jnp.float32) * (HEAD_DIM ** -0.5)
    qpos = jnp.arange(BLOCK)[:, None] + BLOCK
    kpos = jnp.arange(2 * BLOCK)[None, :]
    dist = qpos - kpos
    band = (dist >= 0) & (dist < WINDOW)
    abs_k = jnp.arange(nb)[:, None, None] * BLOCK + kpos[None] - BLOCK
    valid = band[None] & (abs_k >= 0)
    scores = jnp.where(valid[None, :, None, None], scores, -jnp.inf)
    sink = sinks.astype(jnp.float32).reshape(N_KV_HEADS, Q_REP)[None, None, :, :, None, None]
    m = jnp.maximum(jnp.max(scores, axis=-1, keepdims=True), sink)
    p = jnp.exp(scores - m)
    probs = p / (jnp.sum(p, axis=-1, keepdims=True) + jnp.exp(sink - m))
    out = jnp.einsum("bngrqk,bnkgd->bnqgrd", probs.astype(vb.dtype), vb)
    return out.reshape(B, S, Q_WIDTH)


def setup_inputs(seed: int = 0) -> dict:
    key = jax.random.key(seed)
    ks = jax.random.split(key, 20)
    f32 = jnp.float32
    nrm = lambda k, shape, s: jax.random.normal(k, shape, f32) * s
    D = D_MODEL
    return {
        "x": nrm(ks[0], (BATCH, SEQ, D), 1.0),
        "c": nrm(ks[1], (BATCH, D), 1.0),
        "w_ada": nrm(ks[2], (DEPTH, D, N_MOD * D), 0.5 * D ** -0.5),
        "b_ada": nrm(ks[3], (DEPTH, N_MOD * D), 0.02),
        "g_norm_mix": 1.0 + nrm(ks[4], (DEPTH, D), 0.02),
        "w_in": nrm(ks[5], (DEPTH, D, IN_WIDTH), D ** -0.5),
        "b_in": nrm(ks[6], (DEPTH, IN_WIDTH), 0.02),
        "gm_ln_g": 1.0 + nrm(ks[7], (DEPTH, GM_WIDTH), 0.02),
        "gm_ln_b": nrm(ks[8], (DEPTH, GM_WIDTH), 0.02),
        "gm_ws": nrm(ks[9], (DEPTH, GM_GROUPS, CHUNK, CHUNK), CHUNK ** -0.5),
        "gm_bs": 1.0 + nrm(ks[10], (DEPTH, GM_GROUPS, CHUNK), 0.02),
        "attn_sinks": nrm(ks[11], (DEPTH, N_Q_HEADS), 0.5),
        "w_branch_a": nrm(ks[12], (DEPTH, GM_WIDTH, D), GM_WIDTH ** -0.5),
        "w_branch_b": nrm(ks[13], (DEPTH, Q_WIDTH, D), Q_WIDTH ** -0.5),
        "w_out": nrm(ks[14], (DEPTH, D, D), D ** -0.5),
        "g_norm_mlp": 1.0 + nrm(ks[15], (DEPTH, D), 0.02),
        "w_up": nrm(ks[16], (DEPTH, D, D_FF), D ** -0.5),
        "w_down": nrm(ks[17], (DEPTH, D_FF, D), D_FF ** -0.5),
        "g_final": 1.0 + nrm(ks[18], (D,), 0.02),
    }


def reference(x, c, w_ada, b_ada, g_norm_mix, w_in, b_in, gm_ln_g, gm_ln_b, gm_ws, gm_bs,
              attn_sinks, w_branch_a, w_branch_b, w_out, g_norm_mlp, w_up, w_down, g_final):
    D = D_MODEL
    o_u, o_v = 0, GM_WIDTH
    o_q = 2 * GM_WIDTH
    o_k = o_q + Q_WIDTH
    o_va = o_k + KV_WIDTH
    o_ga = o_va + KV_WIDTH
    o_gb = o_ga + D
    for l in range(DEPTH):
        mod = jax.nn.silu(c) @ w_ada[l] + b_ada[l]
        sh_mix, sc_mix, gt_mix, sh_mlp, sc_mlp, gt_mlp = [m[:, None, :] for m in jnp.split(mod, N_MOD, axis=-1)]

        h = rmsnorm(x, g_norm_mix[l]) * (1.0 + sc_mix) + sh_mix
        z = h @ w_in[l] + b_in[l]
        ya = gmlp_spatial_gating(z[..., o_u:o_v], z[..., o_v:o_q], gm_ln_g[l], gm_ln_b[l], gm_ws[l], gm_bs[l])
        yb = sliding_window_sink_attention(z[..., o_q:o_k], z[..., o_k:o_va], z[..., o_va:o_ga], attn_sinks[l])
        merged = jax.nn.sigmoid(z[..., o_ga:o_gb]) * (ya @ w_branch_a[l]) \
            + jax.nn.sigmoid(z[..., o_gb:]) * (yb @ w_branch_b[l])
        x = x + gt_mix * (merged @ w_out[l])

        h = rmsnorm(x, g_norm_mlp[l]) * (1.0 + sc_mlp) + sh_mlp
        x = x + gt_mlp * (jnp.square(jax.nn.relu(h @ w_up[l])) @ w_down[l])
    return rmsnorm(x, g_final)
```

```cpp
#include <hip/hip_runtime.h>
#include <cstdio>
#include <cstdint>

namespace pg8 {
#define PG8_LAS __attribute__((address_space(3)))
typedef unsigned short bf16_t;
typedef short bf16x8 __attribute__((ext_vector_type(8)));
typedef float f32x4 __attribute__((ext_vector_type(4)));
typedef float f32x2 __attribute__((ext_vector_type(2)));
typedef unsigned u32x4 __attribute__((ext_vector_type(4)));
constexpr int BM = 256, BK = 64, HALF = 128, HTB = HALF * BK * 2  , STAGE_BYTES = 8 * HTB, NXCD = 8, WGM = 8;

__host__ __device__ __forceinline__ int lds_byte(int r, int c) { const int st = (r >> 4) * 2 + (c >> 5), rr = r & 15, cc = c & 31, ob = rr * 64 + cc * 2; return st * 1024 + (ob ^ (((ob >> 9) & 1) << 5)); }
__host__ __device__ __forceinline__ void stage_rc(int b, int& R, int& C) { const int st = b / 1024, sb = b % 1024, swz = sb ^ (((sb >> 9) & 1) << 5); R = (st >> 1) * 16 + swz / 64; C = (st & 1) * 32 + (swz % 64) / 2; }
__host__ __device__ __forceinline__ int perm32(int rho) { const int n = rho >> 4, i = rho & 15; return 8 * (i >> 2) + 4 * n + (i & 3); }

struct Unit { int pm, pn, sub; size_t aoff, boff; };
struct Gemm { const bf16_t* A; const bf16_t* Bt; int lda, K; };

struct StaticOrder {
    int nM, nN, nwg, G, c, lda, K;
    __host__ __device__ void init(int M, int N, int K_, int lda_, int G_, int c_) { nM = M / BM; nN = N / BM; nwg = nM * nN; G = G_; c = c_; lda = lda_; K = K_; }
    __host__ __device__ bool next(int i, Unit& u) const {
        const long L = (long)i * G + c; if (L >= nwg) return false;
        int wgid = (int)L; { const int q = nwg / NXCD, r = nwg % NXCD, xcd = wgid % NXCD, off = wgid / NXCD; wgid = (xcd < r ? xcd * (q + 1) : r * (q + 1) + (xcd - r) * q) + off; }
        const int nig = WGM * nN, gid = wgid / nig, fm = gid * WGM, gsz = (nM - fm) < WGM ? (nM - fm) : WGM;
        u.pm = fm + ((wgid % nig) % gsz); u.pn = (wgid % nig) / gsz; u.sub = 0;
        u.aoff = (size_t)u.pm * BM * lda * 2; u.boff = (size_t)u.pn * BM * K * 2; return true;
    }
    __device__ __forceinline__ void a_ready(const Unit&) const {}
    __device__ __forceinline__ void done(const Unit&) const {}
};
struct PairOrder {
    StaticOrder S; int N;
    __host__ __device__ void init(int M, int N_, int K_, int lda_, int G_, int c_) { S.init(M, N_, K_, lda_, G_, c_); N = N_; }
    __host__ __device__ bool next(int i, Unit& u) const {
        if (!S.next(i >> 1, u)) return false;
        u.sub = i & 1; if (u.sub) { u.aoff += (size_t)S.K * 2; u.boff += (size_t)N * S.K * 2; } return true;
    }
    __device__ __forceinline__ void a_ready(const Unit&) const {}
    __device__ __forceinline__ void done(const Unit&) const {}
};

__device__ __forceinline__ unsigned cvt_pk_bf16(float lo, float hi) { unsigned r; asm volatile("v_cvt_pk_bf16_f32 %0, %1, %2" : "=v"(r) : "v"(lo), "v"(hi)); return r; }
__device__ __forceinline__ float bf_lo(unsigned w) { return __uint_as_float(w << 16); }
__device__ __forceinline__ float bf_hi(unsigned w) { return __uint_as_float(w & 0xffff0000u); }
__device__ __forceinline__ float gelu_tanh(float x) { const float y = x * (1.0f + 0.044715f * x * x); const float e = __builtin_amdgcn_exp2f(-2.3022082f * y); return x * __builtin_amdgcn_rcpf(1.0f + e); }
__device__ __forceinline__ float sigmoid_f(float x) { const float e = __builtin_amdgcn_exp2f(-1.44269504f * x); return __builtin_amdgcn_rcpf(1.0f + e); }

struct EpiIn {
    static constexpr bool PERM = true, AFTER_DRAIN = false;
    const float* bias; bf16_t *AB, *VG, *KB, *VB, *SGA, *SGB; float* stats; float qscale;
    __device__ __forceinline__ void operator()(const f32x4 (&acc)[2][2][4][2], const Unit& u, int wr, int wc, int fr, int fq) const {
        const int pn = u.pn; int kind, ldo, colt; bf16_t* base;
        if (pn < 4)        { kind = 0; base = AB;        ldo = 2048; colt = pn * BM; }
        else if (pn < 8)   { kind = 1; base = VG;        ldo = 1024; colt = (pn - 4) * BM; }
        else if (pn < 12)  { kind = 2; base = AB + 1024; ldo = 2048; colt = (pn - 8) * BM; }
        else if (pn == 12) { kind = 3; base = KB;        ldo = 256;  colt = 0; }
        else if (pn == 13) { kind = 3; base = VB;        ldo = 256;  colt = 0; }
        else if (pn < 18)  { kind = 4; base = SGA;       ldo = 1024; colt = (pn - 14) * BM; }
        else               { kind = 4; base = SGB;       ldo = 1024; colt = (pn - 18) * BM; }
        const int row0 = u.pm * BM + wr * 64 + fr;
        const int col0 = colt + wc * 32 + 8 * fq, bcol0 = pn * BM + wc * 32 + 8 * fq;
        f32x4 bv[2][2];
#pragma unroll
        for (int bj = 0; bj < 2; ++bj)
#pragma unroll
            for (int n = 0; n < 2; ++n) bv[bj][n] = *(const f32x4*)(bias + bcol0 + bj * HALF + 4 * n);
#pragma unroll
        for (int ai = 0; ai < 2; ++ai)
#pragma unroll
            for (int m = 0; m < 4; ++m) { const int row = row0 + ai * HALF + m * 16; bf16_t* rowp = base + (size_t)row * ldo + col0; float s1 = 0.f, s2 = 0.f;
#pragma unroll
                for (int bj = 0; bj < 2; ++bj) { f32x4 v0 = acc[ai][bj][m][0] + bv[bj][0], v1 = acc[ai][bj][m][1] + bv[bj][1];
                    if (kind <= 1) {
#pragma unroll
                        for (int e = 0; e < 4; ++e) { v0[e] = gelu_tanh(v0[e]); v1[e] = gelu_tanh(v1[e]); }
                        if (kind == 1) {
#pragma unroll
                            for (int e = 0; e < 4; ++e) { s1 += v0[e] + v1[e]; s2 += v0[e] * v0[e] + v1[e] * v1[e]; } }
                    } else if (kind == 2) { v0 = v0 * qscale; v1 = v1 * qscale; }
                    else if (kind == 4) {
#pragma unroll
                        for (int e = 0; e < 4; ++e) { v0[e] = sigmoid_f(v0[e]); v1[e] = sigmoid_f(v1[e]); } }
                    u32x4 w; w.x = cvt_pk_bf16(v0[0], v0[1]); w.y = cvt_pk_bf16(v0[2], v0[3]); w.z = cvt_pk_bf16(v1[0], v1[1]); w.w = cvt_pk_bf16(v1[2], v1[3]);
                    *(u32x4*)(rowp + bj * HALF) = w; }
                if (kind == 1) { s1 += __shfl_xor(s1, 16); s2 += __shfl_xor(s2, 16); s1 += __shfl_xor(s1, 32); s2 += __shfl_xor(s2, 32);
                    if (fq == 0) *(f32x2*)(stats + ((size_t)row * 16 + (pn - 4) * 4 + wc) * 2) = (f32x2){s1, s2}; } }
    }
};
struct EpiMerge {
    static constexpr bool PERM = true, AFTER_DRAIN = false;
    const bf16_t *SGA, *SGB; bf16_t* MG; f32x4* scratch;
    __device__ __forceinline__ void operator()(const f32x4 (&acc)[2][2][4][2], const Unit& u, int wr, int wc, int fr, int fq) const {
        const int row0 = u.pm * BM + wr * 64 + fr, col0 = u.pn * BM + wc * 32 + 8 * fq, tid = threadIdx.x;
        const bf16_t* Gt = u.sub ? SGB : SGA;
        f32x4* sp = scratch + tid;
#pragma unroll
        for (int ai = 0; ai < 2; ++ai)
#pragma unroll
            for (int m = 0; m < 4; ++m) { const size_t ro = (size_t)(row0 + ai * HALF + m * 16) * 1024 + col0;
#pragma unroll
                for (int bj = 0; bj < 2; ++bj) { const u32x4 gw = *(const u32x4*)(Gt + ro + bj * HALF);
                    f32x4 v0 = acc[ai][bj][m][0] * (f32x4){bf_lo(gw.x), bf_hi(gw.x), bf_lo(gw.y), bf_hi(gw.y)};
                    f32x4 v1 = acc[ai][bj][m][1] * (f32x4){bf_lo(gw.z), bf_hi(gw.z), bf_lo(gw.w), bf_hi(gw.w)};
                    if (u.sub == 0) { sp[0] = v0; sp[512] = v1; }
                    else { v0 = v0 + sp[0]; v1 = v1 + sp[512];
                        u32x4 w; w.x = cvt_pk_bf16(v0[0], v0[1]); w.y = cvt_pk_bf16(v0[2], v0[3]); w.z = cvt_pk_bf16(v1[0], v1[1]); w.w = cvt_pk_bf16(v1[2], v1[3]);
                        *(u32x4*)(MG + ro + bj * HALF) = w; }
                    sp += 1024; asm volatile("" : "+v"(sp)); }
                asm volatile("" ::: "memory"); }
    }
};
struct EpiRes {
    static constexpr bool PERM = false, AFTER_DRAIN = false;
    const float* base; float* out; const float* gate;
    __device__ __forceinline__ void operator()(const f32x4 (&acc)[2][2][4][2], const Unit& u, int wr, int wc, int fr, int fq) const {
        const int row0 = u.pm * BM + wr * 64 + fr, col0 = u.pn * BM + wc * 32 + 4 * fq;
        const float* gt = gate + (size_t)(u.pm >> 4) * 6144;
        f32x4 gv[2][2];
#pragma unroll
        for (int bj = 0; bj < 2; ++bj)
#pragma unroll
            for (int n = 0; n < 2; ++n) gv[bj][n] = *(const f32x4*)(gt + col0 + bj * HALF + n * 16);
#pragma unroll
        for (int ai = 0; ai < 2; ++ai)
#pragma unroll
            for (int m = 0; m < 4; ++m) { const size_t off = (size_t)(row0 + ai * HALF + m * 16) * 1024 + col0;
#pragma unroll
                for (int bj = 0; bj < 2; ++bj)
#pragma unroll
                    for (int n = 0; n < 2; ++n) { const f32x4 bs = *(const f32x4*)(base + off + bj * HALF + n * 16); *(f32x4*)(out + off + bj * HALF + n * 16) = bs + gv[bj][n] * acc[ai][bj][m][n]; }
                if (m & 1) asm volatile("" ::: "memory"); }
    }
};
struct EpiUp {
    static constexpr bool PERM = true, AFTER_DRAIN = false;
    bf16_t* O; int ldc;
    __device__ __forceinline__ void operator()(const f32x4 (&acc)[2][2][4][2], const Unit& u, int wr, int wc, int fr, int fq) const {
        const int row0 = u.pm * BM + wr * 64 + fr, col0 = u.pn * BM + wc * 32 + 8 * fq;
#pragma unroll
        for (int ai = 0; ai < 2; ++ai)
#pragma unroll
            for (int m = 0; m < 4; ++m) { bf16_t* rowp = O + (size_t)(row0 + ai * HALF + m * 16) * ldc + col0;
#pragma unroll
                for (int bj = 0; bj < 2; ++bj) { f32x4 v0 = acc[ai][bj][m][0], v1 = acc[ai][bj][m][1];
#pragma unroll
                    for (int e = 0; e < 4; ++e) { const float a = fmaxf(v0[e], 0.f), b = fmaxf(v1[e], 0.f); v0[e] = a * a; v1[e] = b * b; }
                    u32x4 w; w.x = cvt_pk_bf16(v0[0], v0[1]); w.y = cvt_pk_bf16(v0[2], v0[3]); w.z = cvt_pk_bf16(v1[0], v1[1]); w.w = cvt_pk_bf16(v1[2], v1[3]);
                    *(u32x4*)(rowp + bj * HALF) = w; } }
    }
};

template <class Epi, class Sched, bool ALIGN_EPI = false, bool SP2 = false>
__device__ __forceinline__ void gemm_phase(PG8_LAS unsigned char* lds, const Gemm g, const Sched& S, const Epi& E) {
    const int tid = threadIdx.x, wid = __builtin_amdgcn_readfirstlane(tid >> 6), lane = tid & 63, wr = wid >> 2, wc = wid & 3, fr = lane & 15, fq = lane >> 4;
    const int K = g.K, nt = K / BK, lda = g.lda;
    unsigned voffA[2], voffB[2];
#pragma unroll
    for (int i = 0; i < 2; ++i) { int R, C; stage_rc(tid * 16 + i * 8192, R, C); const int Rb = Epi::PERM ? ((R & ~31) + perm32(R & 31)) : R;
        voffA[i] = (unsigned)(R * lda + C) * 2u; voffB[i] = (unsigned)(Rb * K + C) * 2u; }
    const size_t kstep = (size_t)(BK * 2);
    const size_t hstep = (size_t)HALF * K * 2, hstepA = (size_t)HALF * lda * 2;
    const size_t tstep = 2 * hstep;
    const unsigned ldsw = (unsigned)wid * 1024u;
    const int aoff = lds_byte(wr * 64 + fr, fq * 8), boff = lds_byte(wc * 32 + fr, fq * 8);
#define PG8_SA(b, h) (((b) * 2 + (h)) * HTB)
#define PG8_SB(b, h) ((4 + (b) * 2 + (h)) * HTB)
#define PG8_STAGE(bufoff, gbase, voff) do { _Pragma("unroll") for (int _i = 0; _i < 2; ++_i) \
        __builtin_amdgcn_global_load_lds((const unsigned*)((const char*)(gbase) + (voff)[_i]), (PG8_LAS unsigned*)(lds + (bufoff) + ldsw + _i * 8192), 16, 0, 0); } while (0)
#define PG8_LDA(dst, b, h) do { _Pragma("unroll") for (int m = 0; m < 4; ++m) _Pragma("unroll") for (int k = 0; k < 2; ++k) dst[m][k] = *(const PG8_LAS bf16x8*)(lds + PG8_SA(b, h) + aoff + m * 2048 + k * 1024); } while (0)
#define PG8_LDB(dst, b, h) do { _Pragma("unroll") for (int n = 0; n < 2; ++n) _Pragma("unroll") for (int k = 0; k < 2; ++k) dst[n][k] = *(const PG8_LAS bf16x8*)(lds + PG8_SB(b, h) + boff + n * 2048 + k * 1024); } while (0)
#define PG8_MMA(ai, bj, At, Bt) do { __builtin_amdgcn_s_setprio(1); _Pragma("unroll") for (int m = 0; m < 4; ++m) _Pragma("unroll") for (int n = 0; n < 2; ++n) _Pragma("unroll") for (int k = 0; k < 2; ++k) \
        acc[ai][bj][m][n] = __builtin_amdgcn_mfma_f32_16x16x32_bf16(Bt[n][k], At[m][k], acc[ai][bj][m][n], 0, 0, 0); __builtin_amdgcn_s_setprio(0); } while (0)
#define PG8_WAIT_V(n) asm volatile("s_waitcnt vmcnt(" #n ")" ::: "memory")
#define PG8_WAIT_L(n) asm volatile("s_waitcnt lgkmcnt(" #n ")" ::: "memory")
#define PG8_BAR __builtin_amdgcn_s_barrier()
#define PG8_SCHED __builtin_amdgcn_sched_barrier(0)
    Unit cur, nxt; int ui = 0;
    if (!S.next(0, cur)) return;
    f32x4 acc[2][2][4][2];
#pragma unroll
    for (int a = 0; a < 2; ++a)
#pragma unroll
        for (int b = 0; b < 2; ++b)
#pragma unroll
            for (int m = 0; m < 4; ++m)
#pragma unroll
                for (int n = 0; n < 2; ++n) acc[a][b][m][n] = (f32x4){0.f, 0.f, 0.f, 0.f};
    bf16x8 At[4][2], B0[2][2], B1[2][2];
    const char* cA = (const char*)g.A + cur.aoff; const char* cB = (const char*)g.Bt + cur.boff;
    S.a_ready(cur);
    if constexpr (SP2) {
        PG8_STAGE(PG8_SB(0, 0), cB, voffB); PG8_STAGE(PG8_SB(0, 1), cB + hstep, voffB); PG8_STAGE(PG8_SA(0, 0), cA, voffA); PG8_STAGE(PG8_SA(0, 1), cA + hstepA, voffA);
        if (wr == 1) PG8_BAR;
        PG8_WAIT_V(2); PG8_BAR;
        PG8_STAGE(PG8_SB(1, 0), cB + kstep, voffB); PG8_STAGE(PG8_SA(1, 0), cA + kstep, voffA); PG8_STAGE(PG8_SB(1, 1), cB + hstep + kstep, voffB);
        PG8_WAIT_V(6); PG8_BAR;
    } else {
        PG8_STAGE(PG8_SB(0, 0), cB, voffB); PG8_STAGE(PG8_SA(0, 0), cA, voffA); PG8_STAGE(PG8_SB(0, 1), cB + hstep, voffB); PG8_STAGE(PG8_SA(0, 1), cA + hstepA, voffA);
        if (wr == 1) PG8_BAR;
        PG8_WAIT_V(4); PG8_BAR;
        PG8_STAGE(PG8_SB(1, 0), cB + kstep, voffB); PG8_STAGE(PG8_SA(1, 0), cA + kstep, voffA); PG8_STAGE(PG8_SB(1, 1), cB + hstep + kstep, voffB);
        PG8_WAIT_V(6); PG8_BAR;
    }
    for (;;) {
        const bool has_next = S.next(ui + 1, nxt);
        const char* nA = has_next ? (const char*)g.A + nxt.aoff : cA; const char* nB = has_next ? (const char*)g.Bt + nxt.boff : cB;
        for (int t = 0; t < nt; t += 2) {
            const bool last = (t == nt - 2);
            const char* a1 = cA + (size_t)(t + 1) * kstep;
            const char* a2 = last ? nA : cA + (size_t)(t + 2) * kstep; const char* b2 = last ? nB : cB + (size_t)(t + 2) * kstep;
            const char* a3 = a2 + kstep; const char* b3 = b2 + kstep;
            if (last && has_next) S.a_ready(nxt);
            if constexpr (SP2) {
            PG8_LDB(B0, 0, 0); PG8_LDB(B1, 0, 1); PG8_SCHED; PG8_LDA(At, 0, 0); PG8_STAGE(PG8_SA(1, 1), a1 + hstepA, voffA);
            PG8_WAIT_V(8); PG8_WAIT_L(0); PG8_BAR; PG8_MMA(0, 0, At, B0); PG8_MMA(0, 1, At, B1); PG8_BAR; PG8_SCHED;
            PG8_LDA(At, 0, 1); PG8_STAGE(PG8_SB(0, 0), b2, voffB); PG8_STAGE(PG8_SB(0, 1), b2 + hstep, voffB); PG8_STAGE(PG8_SA(0, 0), a2, voffA);
            PG8_WAIT_V(8); PG8_WAIT_L(0); PG8_BAR; PG8_MMA(1, 0, At, B0); PG8_MMA(1, 1, At, B1); PG8_BAR; PG8_SCHED;
            PG8_LDB(B0, 1, 0); PG8_LDB(B1, 1, 1); PG8_SCHED; PG8_LDA(At, 1, 0); PG8_STAGE(PG8_SA(0, 1), a2 + hstepA, voffA);
            PG8_WAIT_V(8); PG8_WAIT_L(0); PG8_BAR; PG8_MMA(0, 0, At, B0); PG8_MMA(0, 1, At, B1); PG8_BAR; PG8_SCHED;
            PG8_LDA(At, 1, 1); PG8_STAGE(PG8_SB(1, 0), b3, voffB); PG8_STAGE(PG8_SB(1, 1), b3 + hstep, voffB); PG8_STAGE(PG8_SA(1, 0), a3, voffA);
            PG8_WAIT_V(8); PG8_WAIT_L(0); PG8_BAR; PG8_MMA(1, 0, At, B0); PG8_MMA(1, 1, At, B1); PG8_BAR; PG8_SCHED;
            } else {
            PG8_LDB(B0, 0, 0); PG8_SCHED; PG8_LDA(At, 0, 0); PG8_STAGE(PG8_SA(1, 1), a1 + hstepA, voffA);
            PG8_WAIT_L(8); PG8_BAR; PG8_WAIT_L(0); PG8_MMA(0, 0, At, B0); PG8_BAR; PG8_SCHED;
            PG8_LDB(B1, 0, 1); PG8_STAGE(PG8_SB(0, 0), b2, voffB);
            PG8_BAR; PG8_WAIT_L(0); PG8_MMA(0, 1, At, B1); PG8_BAR;
            PG8_LDA(At, 0, 1); PG8_STAGE(PG8_SA(0, 0), a2, voffA);
            PG8_BAR; PG8_WAIT_L(0); PG8_MMA(1, 0, At, B0); PG8_BAR; PG8_SCHED;
            PG8_STAGE(PG8_SB(0, 1), b2 + hstep, voffB);
            PG8_WAIT_V(6); PG8_BAR; PG8_MMA(1, 1, At, B1); PG8_BAR;
            PG8_LDB(B0, 1, 0); PG8_SCHED; PG8_LDA(At, 1, 0); PG8_STAGE(PG8_SA(0, 1), a2 + hstepA, voffA);
            PG8_WAIT_L(8); PG8_BAR; PG8_WAIT_L(0); PG8_MMA(0, 0, At, B0); PG8_BAR; PG8_SCHED;
            PG8_LDB(B1, 1, 1); PG8_STAGE(PG8_SB(1, 0), b3, voffB);
            PG8_BAR; PG8_WAIT_L(0); PG8_MMA(0, 1, At, B1); PG8_BAR;
            PG8_LDA(At, 1, 1); PG8_STAGE(PG8_SA(1, 0), a3, voffA);
            PG8_BAR; PG8_WAIT_L(0); PG8_MMA(1, 0, At, B0); PG8_BAR; PG8_SCHED;
            PG8_STAGE(PG8_SB(1, 1), b3 + hstep, voffB);
            PG8_WAIT_V(6); PG8_BAR; PG8_MMA(1, 1, At, B1); PG8_BAR;
            }
        }
        if constexpr (ALIGN_EPI) { if (wr == 0) PG8_BAR; }
        if constexpr (!Epi::AFTER_DRAIN) { E(acc, cur, wr, wc, fr, fq); S.done(cur); }
        if (!has_next) break;
#pragma unroll
        for (int a = 0; a < 2; ++a)
#pragma unroll
            for (int b = 0; b < 2; ++b)
#pragma unroll
                for (int m = 0; m < 4; ++m)
#pragma unroll
                    for (int n = 0; n < 2; ++n) acc[a][b][m][n] = (f32x4){0.f, 0.f, 0.f, 0.f};
        cur = nxt; cA = nA; cB = nB; ++ui;
        if constexpr (ALIGN_EPI) { if (wr == 1) PG8_BAR; }
    }
    PG8_WAIT_V(0);
    if constexpr (!ALIGN_EPI) { if (wr == 0) PG8_BAR; }
    PG8_BAR;
    if constexpr (Epi::AFTER_DRAIN) { E.fused(acc, cur, wr, wc, fr, fq, lds, wid, lane); S.done(cur); }
#undef PG8_SA
#undef PG8_SB
#undef PG8_STAGE
#undef PG8_LDA
#undef PG8_LDB
#undef PG8_MMA
#undef PG8_WAIT_V
#undef PG8_WAIT_L
#undef PG8_BAR
#undef PG8_SCHED
}
}

#define GAS __attribute__((address_space(1)))
#define LAS __attribute__((address_space(3)))
typedef unsigned short bf16;
typedef unsigned v4u __attribute__((ext_vector_type(4)));
typedef float f32x4 __attribute__((ext_vector_type(4)));
typedef short bf16x8 __attribute__((ext_vector_type(8)));
typedef GAS unsigned gu32;
typedef GAS unsigned long long gu64;
#define RLX_AGENT __ATOMIC_RELAXED, __HIP_MEMORY_SCOPE_AGENT
#define LDS_WAIT() asm volatile("s_waitcnt lgkmcnt(0)" ::: "memory")
#define VM_WAIT() asm volatile("s_waitcnt vmcnt(0)" ::: "memory")
__device__ __forceinline__ unsigned long long rt() { return __builtin_amdgcn_s_memrealtime(); }
__device__ __forceinline__ unsigned f2bf(float f) { unsigned u = __builtin_bit_cast(unsigned, f); return (u + 0x7fffu + ((u >> 16) & 1u)) >> 16; }
__device__ __forceinline__ unsigned pk2(float lo, float hi) { return f2bf(lo) | (f2bf(hi) << 16); }

#define XB_TMO      128
#define XB_XCNT(j)  (256  + 64 * (j))
#define XB_XSUB(j)  (1280 + 64 * (j))
#define XB_XGEN(j)  (2304 + 64 * (j))
#define XB_TOP      3328
#define XB_TOPGEN   3392
#define XCD_BAR_WORDS 3456
#define XB_SPIN_CAP (1u << 18)

__device__ __forceinline__ unsigned xb_ld(unsigned* p)              { return __hip_atomic_load(p, __ATOMIC_RELAXED, __HIP_MEMORY_SCOPE_AGENT); }
__device__ __forceinline__ unsigned xb_add(unsigned* p, unsigned v) { return __hip_atomic_fetch_add(p, v, __ATOMIC_RELAXED, __HIP_MEMORY_SCOPE_AGENT); }
__device__ __forceinline__ unsigned xb_xcc_id() { return (unsigned)__builtin_amdgcn_s_getreg((3 << 11) | 20) & 0xFu; }
#define XB_SPIN(cond, bar) do { unsigned _sp = 0; while (cond) { __builtin_amdgcn_s_sleep(1); \
    if ((++_sp & 255u) == 0u) { if (xb_ld(&(bar)[XB_TMO])) break; if (_sp > XB_SPIN_CAP) { atomicAdd(&(bar)[XB_TMO], 1u); break; } } } } while (0)

struct XcdBarrier {
    unsigned* bar; unsigned x;
    volatile LAS unsigned* st;
};

__device__ __forceinline__ XcdBarrier xcd_barrier_post(unsigned* bar, volatile LAS unsigned* st) {
    XcdBarrier b; b.bar = bar; b.x = xb_xcc_id(); b.st = st;
    if (threadIdx.x == 0) (void)xb_add(&bar[XB_XCNT(b.x)], 1u);
    return b;
}
__device__ __forceinline__ void xcd_barrier_complete(unsigned* bar, unsigned x, unsigned& nloc, unsigned& nx) {
    const unsigned G = gridDim.x * gridDim.y * gridDim.z;
    unsigned sum, cnt, mine, sp = 0u;
    for (;;) {
        sum = 0u; cnt = 0u; mine = 0u;
#pragma unroll
        for (unsigned j = 0; j < 16; ++j) { const unsigned c = xb_ld(&bar[XB_XCNT(j)]); sum += c; cnt += (c > 0u) ? 1u : 0u; mine = (j == x) ? c : mine; }
        if (sum == G) break;
        __builtin_amdgcn_s_sleep(1);
        if ((++sp & 255u) == 0u) { if (xb_ld(&bar[XB_TMO])) break; if (sp > XB_SPIN_CAP) { atomicAdd(&bar[XB_TMO], 1u); break; } }
    }
    nloc = mine > 0u ? mine : 1u; nx = cnt > 0u ? cnt : 1u;
}

__device__ __forceinline__ void xcd_barrier(const XcdBarrier& b) {
    asm volatile("s_waitcnt vmcnt(0)" ::: "memory");
    __syncthreads();
    if (threadIdx.x == 0) {
        unsigned* bar = b.bar;
        __builtin_amdgcn_s_waitcnt(0);
        unsigned nloc = b.st[0], nx = b.st[1];
        if (nloc == 0u) { xcd_barrier_complete(bar, b.x, nloc, nx); b.st[0] = nloc; b.st[1] = nx; }
        const unsigned old = xb_add(&bar[XB_XSUB(b.x)], 1u);
        const unsigned gen = old / nloc;
        if (old + 1u == (gen + 1u) * nloc) {
            __builtin_amdgcn_fence(__ATOMIC_RELEASE, "agent");
            asm volatile("s_waitcnt vmcnt(0)" ::: "memory");
            const unsigned og = xb_add(&bar[XB_TOP], 1u);
            const unsigned tg = og / nx;
            if (og + 1u == (tg + 1u) * nx) xb_add(&bar[XB_TOPGEN], 1u);
            else XB_SPIN(xb_ld(&bar[XB_TOPGEN]) == tg, bar);
            __builtin_amdgcn_fence(__ATOMIC_ACQUIRE, "agent");
            xb_add(&bar[XB_XGEN(b.x)], 1u);
            asm volatile("s_waitcnt vmcnt(0)" ::: "memory");
        } else {
            XB_SPIN(xb_ld(&bar[XB_XGEN(b.x)]) == gen, bar);
            __builtin_amdgcn_fence(__ATOMIC_ACQUIRE, "agent");
            asm volatile("s_waitcnt vmcnt(0)" ::: "memory");
        }
    }
    __syncthreads();
}

constexpr int NWAVES = 8;
constexpr int BATCH = 8, SEQ = 4096, D = 1024, FF = 4096, M = BATCH * SEQ;
constexpr int INW = 5632, NMOD = 6 * D, CHUNK = 128, NQH = 16, NKVH = 4, HD = 64;
constexpr float EPS = 1e-6f, LOG2E = 1.4426950408889634f;
constexpr float QSCALE = 0.125f * LOG2E;
constexpr int KCH = 16;

constexpr size_t MiB = 1u << 20;
constexpr size_t WS_CTL = 0, CTL_ZERO_BYTES = 1 * MiB;
constexpr size_t WS_MODP = 1 * MiB;
constexpr size_t WS_MODF = 4 * MiB;
constexpr size_t WS_STATS = 5 * MiB;
constexpr size_t WS_WIN = 10 * MiB, WS_WAB = 21 * MiB, WS_WOUT = 25 * MiB, WS_WUP = 27 * MiB, WS_WDN = 35 * MiB;
constexpr size_t WS_H = 48 * MiB;
constexpr size_t WS_AB = 112 * MiB;
constexpr size_t WS_VG = 240 * MiB;
constexpr size_t WS_KB = 304 * MiB, WS_VB = 320 * MiB;
constexpr size_t WS_SGA = 336 * MiB, WS_SGB = 400 * MiB;
constexpr size_t WS_HB = 112 * MiB;
constexpr size_t WS_END = 464 * MiB;
constexpr int CW_TMO = 0, CW_BAR = 4096;

constexpr int RING_BYTES = 131072;
constexpr int LDSCTL_OFF = RING_BYTES;
constexpr int BARST_OFF = LDSCTL_OFF + 64;
constexpr int XTRA_OFF = LDSCTL_OFF + 1024;
constexpr int LDS_BYTES = 147456;

__device__ __forceinline__ float wave_sum(float v) {
#pragma unroll
    for (int o = 1; o < 64; o <<= 1) v += __shfl_xor(v, o);
    return v;
}
__device__ __forceinline__ float bf2f(bf16 h) { return __uint_as_float((unsigned)h << 16); }

__device__ __forceinline__ void p0_transpose_item(const float* W, int K, int N, bf16* WT, int row_off, LAS float* scr, int item, int lane) {
    const int nblk = N / 32, kb = item / nblk, nb = item % nblk, k0 = 64 * kb, n0 = 32 * nb;
#pragma unroll 8
    for (int i = 0; i < 32; ++i) { const int kk = 2 * i + (lane >> 5); scr[kk * 33 + (lane & 31)] = W[(size_t)(k0 + kk) * N + n0 + (lane & 31)]; }
    LDS_WAIT(); asm volatile("" ::: "memory");
    const int c = lane & 7;
#pragma unroll
    for (int j = 0; j < 4; ++j) { const int n = (lane >> 3) + 8 * j; const LAS float* s = scr + (8 * c) * 33 + n;
        v4u o; o.x = pk2(s[0 * 33], s[1 * 33]); o.y = pk2(s[2 * 33], s[3 * 33]); o.z = pk2(s[4 * 33], s[5 * 33]); o.w = pk2(s[6 * 33], s[7 * 33]);
        *(GAS v4u*)(WT + (size_t)(row_off + n0 + n) * K + k0 + 8 * c) = o; }
    LDS_WAIT(); asm volatile("" ::: "memory");
}

struct Ptrs {
    const float *x, *c, *w_ada, *b_ada, *g_mix, *w_in, *b_in, *ln_g, *ln_b, *gm_ws, *gm_bs, *sinks, *w_a, *w_b, *w_out, *g_mlp, *w_up, *w_down, *g_final;
    float* out; unsigned char* ws;
};

__device__ __forceinline__ void p0_prologue(const Ptrs& P, LAS unsigned char* lds, int vcu, int G, int tid, int lane, int wave) {
    LAS float* sl = (LAS float*)(lds + 8 * 8704);
    for (int i = tid; i < BATCH * D; i += NWAVES * 64) { const float v = P.c[i]; sl[i] = v / (1.0f + __expf(-v)); }
    __syncthreads();
    LAS float* scr = (LAS float*)(lds + wave * 8704);
    float* modp = (float*)(P.ws + WS_MODP);
    const int gw = vcu * NWAVES + wave, NGW = G * NWAVES;
    constexpr int I_MOD = (NMOD / 64) * KCH;
    constexpr int I_IN = (D / 64) * (INW / 32), I_SQ = (D / 64) * (D / 32), I_UP = (D / 64) * (FF / 32), I_DN = (FF / 64) * (D / 32);
    constexpr int NITEMS = I_MOD + I_IN + 3 * I_SQ + I_UP + I_DN;
    bf16* Win_t = (bf16*)(P.ws + WS_WIN); bf16* Wab_t = (bf16*)(P.ws + WS_WAB); bf16* Wout_t = (bf16*)(P.ws + WS_WOUT); bf16* Wup_t = (bf16*)(P.ws + WS_WUP); bf16* Wdn_t = (bf16*)(P.ws + WS_WDN);
    for (int it = gw; it < NITEMS; it += NGW) {
        int r = it;
        if (r < I_MOD) {
            const int nb = r % (NMOD / 64), kc = r / (NMOD / 64), n = nb * 64 + lane, kq = D / KCH;
            float a[BATCH];
#pragma unroll
            for (int b = 0; b < BATCH; ++b) a[b] = 0.f;
            const float* wp = P.w_ada + (size_t)(kc * kq) * NMOD + n;
#pragma unroll 8
            for (int k = 0; k < kq; ++k) { const float w = wp[(size_t)k * NMOD];
#pragma unroll
                for (int b = 0; b < BATCH; ++b) a[b] += sl[b * D + kc * kq + k] * w; }
#pragma unroll
            for (int b = 0; b < BATCH; ++b) modp[(size_t)(kc * BATCH + b) * NMOD + n] = a[b];
            continue; }
        r -= I_MOD;
        if (r < I_IN) { p0_transpose_item(P.w_in, D, INW, Win_t, 0, scr, r, lane); continue; } r -= I_IN;
        if (r < I_SQ) { p0_transpose_item(P.w_a, D, D, Wab_t, 0, scr, r, lane); continue; } r -= I_SQ;
        if (r < I_SQ) { p0_transpose_item(P.w_b, D, D, Wab_t, D, scr, r, lane); continue; } r -= I_SQ;
        if (r < I_SQ) { p0_transpose_item(P.w_out, D, D, Wout_t, 0, scr, r, lane); continue; } r -= I_SQ;
        if (r < I_UP) { p0_transpose_item(P.w_up, D, FF, Wup_t, 0, scr, r, lane); continue; } r -= I_UP;
        p0_transpose_item(P.w_down, FF, D, Wdn_t, 0, scr, r, lane);
    }
}

template <bool OUT_BF16, bool HAS_SH>
__device__ __forceinline__ void norm_row(const float* src, const LAS float* gs, const LAS float* sh, void* dst, int lane) {
    const GAS f32x4* xr = (const GAS f32x4*)src + lane;
    f32x4 v[4]; float s = 0.f;
#pragma unroll
    for (int j = 0; j < 4; ++j) { v[j] = xr[64 * j]; s += (v[j].x * v[j].x + v[j].y * v[j].y) + (v[j].z * v[j].z + v[j].w * v[j].w); }
    const float rstd = 1.0f / sqrtf(wave_sum(s) * (1.0f / D) + EPS);
#pragma unroll
    for (int j = 0; j < 4; ++j) { const f32x4 g = *(const LAS f32x4*)(gs + 4 * lane + 256 * j); f32x4 o = v[j] * rstd * g;
        if (HAS_SH) o = o + *(const LAS f32x4*)(sh + 4 * lane + 256 * j);
        if (OUT_BF16) ((GAS unsigned long long*)dst)[lane + 64 * j] = (unsigned long long)pk2(o.x, o.y) | ((unsigned long long)pk2(o.z, o.w) << 32);
        else ((GAS f32x4*)dst)[lane + 64 * j] = o; }
}

__device__ __forceinline__ void gate_unit_valu(const Ptrs& P, unsigned char* lds, int un, int tid) {
    float* Wt = (float*)lds; float* Vt = (float*)(lds + 65536);
    float* mu = (float*)(lds + XTRA_OFF); float* rs = mu + 128;
    const float* stats = (const float*)(P.ws + WS_STATS); const bf16* VG = (const bf16*)(P.ws + WS_VG); bf16* AB = (bf16*)(P.ws + WS_AB);
    const size_t R0 = (size_t)un * CHUNK;
    if (tid < 128) { float s1 = 0.f, s2 = 0.f; const float* sp = stats + (R0 + tid) * 32;
        for (int p = 0; p < 16; ++p) { s1 += sp[2 * p]; s2 += sp[2 * p + 1]; }
        const float mean = s1 * (1.0f / D), var = fmaxf(s2 * (1.0f / D) - mean * mean, 0.f); mu[tid] = mean; rs[tid] = 1.0f / sqrtf(var + EPS); }
    __syncthreads();
    for (int g = 0; g < 8; ++g) {
        for (int i = tid; i < 16384; i += 512) { const int t = i >> 7, s = i & 127;
            Wt[i] = (s <= t) ? P.gm_ws[(size_t)(g * 128 + t) * 128 + s] : 0.f;
            const float v = bf2f(VG[(R0 + t) * D + g * 128 + s]);
            Vt[i] = (v - mu[t]) * rs[t] * P.ln_g[g * 128 + s] + P.ln_b[g * 128 + s]; }
        __syncthreads();
        const int c = tid & 127, tq = tid >> 7;
#pragma unroll 1
        for (int ib = 0; ib < 4; ++ib) {
            float a[8];
#pragma unroll
            for (int i = 0; i < 8; ++i) a[i] = 0.f;
            const int t0 = tq * 32 + ib * 8;
            for (int s = 0; s < 128; ++s) { const float v = Vt[s * 128 + c];
#pragma unroll
                for (int i = 0; i < 8; ++i) a[i] += Wt[(t0 + i) * 128 + s] * v; }
#pragma unroll
            for (int i = 0; i < 8; ++i) { const int t = t0 + i; const size_t ad = (R0 + t) * 2048 + g * 128 + c;
                const float uu = bf2f(AB[ad]); AB[ad] = (bf16)f2bf(uu * (a[i] + P.gm_bs[g * 128 + t])); }
        }
        __syncthreads();
    }
}
__device__ __forceinline__ void attn_unit_valu(const Ptrs& P, unsigned char* lds, int un, int tid) {
    float* Kt = (float*)lds; float* Vt = (float*)(lds + 65536);
    bf16* AB = (bf16*)(P.ws + WS_AB); const bf16* KB = (const bf16*)(P.ws + WS_KB); const bf16* VB = (const bf16*)(P.ws + WS_VB);
    const int chunk = un & 31; const long R0 = (long)un * CHUNK;
    for (int g = 0; g < NKVH; ++g) {
        for (int i = tid; i < 16384; i += 512) { const int j = i >> 6, d = i & 63; const bool ok = (chunk > 0) || (j >= 128);
            const long kr = R0 - 128 + j;
            Kt[i] = ok ? bf2f(KB[kr * 256 + g * 64 + d]) : 0.f; Vt[i] = ok ? bf2f(VB[kr * 256 + g * 64 + d]) : 0.f; }
        __syncthreads();
        const int i = tid & 127, r = tid >> 7, h = g * 4 + r;
        bf16* qp = AB + (size_t)(R0 + i) * 2048 + 1024 + h * 64;
        unsigned qw[32]; float o[64];
#pragma unroll
        for (int d = 0; d < 32; ++d) qw[d] = ((const unsigned*)qp)[d];
#pragma unroll
        for (int d = 0; d < 64; ++d) o[d] = 0.f;
        float m = P.sinks[h] * LOG2E, l = 1.0f;
        const int i0 = i & ~63; const int jlo = i0 + 1, jhi = (i0 + 191 < 255) ? i0 + 191 : 255;
        for (int j = jlo; j <= jhi; ++j) {
            float s = 0.f;
#pragma unroll
            for (int d = 0; d < 32; ++d) s += pg8::bf_lo(qw[d]) * Kt[j * 64 + 2 * d] + pg8::bf_hi(qw[d]) * Kt[j * 64 + 2 * d + 1];
            const bool valid = (j > i) && (j <= i + 128) && (chunk > 0 || j >= 128);
            if (valid) { const float mn = fmaxf(m, s), sc = __builtin_amdgcn_exp2f(m - mn), p = __builtin_amdgcn_exp2f(s - mn); l = l * sc + p; m = mn;
#pragma unroll
                for (int d = 0; d < 64; ++d) o[d] = o[d] * sc + p * Vt[j * 64 + d]; }
        }
        const float il = 1.0f / l;
#pragma unroll
        for (int d = 0; d < 64; ++d) qp[d] = (bf16)f2bf(o[d] * il);
        __syncthreads();
    }
}

#ifndef PH_MASK
#define PH_MASK 0x3ff
#endif
struct Args { const float* in[19]; float* out; unsigned char* ws; };
__global__ void __launch_bounds__(NWAVES * 64, 2) fwd_kernel(Args args) {
    extern __shared__ __attribute__((aligned(16))) unsigned char lds[];
    LAS unsigned char* L = (LAS unsigned char*)lds;
    const int tid = threadIdx.x, lane = tid & 63, wave = __builtin_amdgcn_readfirstlane(tid >> 6);
    const int G = gridDim.x, bx = blockIdx.x, vcu = (G % 8 == 0) ? (bx % 8) * (G / 8) + bx / 8 : bx;
    Ptrs P;
    P.x = args.in[0]; P.c = args.in[1]; P.w_ada = args.in[2]; P.b_ada = args.in[3]; P.g_mix = args.in[4]; P.w_in = args.in[5]; P.b_in = args.in[6]; P.ln_g = args.in[7]; P.ln_b = args.in[8];
    P.gm_ws = args.in[9]; P.gm_bs = args.in[10]; P.sinks = args.in[11]; P.w_a = args.in[12]; P.w_b = args.in[13]; P.w_out = args.in[14]; P.g_mlp = args.in[15]; P.w_up = args.in[16]; P.w_down = args.in[17];
    P.g_final = args.in[18]; P.out = args.out; P.ws = args.ws;
    unsigned char* ws = args.ws;
    gu32* ctl = (gu32*)(ws + WS_CTL);
    for (int u = tid; u < (LDS_BYTES - LDSCTL_OFF) / 4; u += NWAVES * 64) ((LAS unsigned*)(L + LDSCTL_OFF))[u] = 0u;
    __syncthreads();
    XcdBarrier bar = xcd_barrier_post((unsigned*)(ctl + CW_BAR), (volatile LAS unsigned*)(L + BARST_OFF));
    bf16* Win_t = (bf16*)(ws + WS_WIN); bf16* Wab_t = (bf16*)(ws + WS_WAB); bf16* Wout_t = (bf16*)(ws + WS_WOUT); bf16* Wup_t = (bf16*)(ws + WS_WUP); bf16* Wdn_t = (bf16*)(ws + WS_WDN);
    bf16* H = (bf16*)(ws + WS_H); bf16* AB = (bf16*)(ws + WS_AB); bf16* VG = (bf16*)(ws + WS_VG); bf16* KB = (bf16*)(ws + WS_KB); bf16* VB = (bf16*)(ws + WS_VB);
    bf16* SGA = (bf16*)(ws + WS_SGA); bf16* SGB = (bf16*)(ws + WS_SGB); bf16* MG = (bf16*)(ws + WS_VG); bf16* HB = (bf16*)(ws + WS_HB);
    float* modp = (float*)(ws + WS_MODP); float* modf = (float*)(ws + WS_MODF); float* stats = (float*)(ws + WS_STATS);
    LAS float* gsL = (LAS float*)(L + 0); LAS float* shL = (LAS float*)(L + 4096);

#if (PH_MASK >> 0) & 1
    p0_prologue(P, L, vcu, G, tid, lane, wave);
#endif
    xcd_barrier(bar);

#if (PH_MASK >> 1) & 1
    {
        const int rows_per = M / G, row0 = vcu * rows_per, b = row0 / SEQ;
        for (int col = tid; col < D; col += NWAVES * 64) { float sh = P.b_ada[col], sc = P.b_ada[D + col];
            for (int kc = 0; kc < KCH; ++kc) { sh += modp[(size_t)(kc * BATCH + b) * NMOD + col]; sc += modp[(size_t)(kc * BATCH + b) * NMOD + D + col]; }
            gsL[col] = P.g_mix[col] * (1.0f + sc); shL[col] = sh; }
        const int per = BATCH * NMOD / G;
        for (int i = tid; i < per; i += NWAVES * 64) { const int idx = vcu * per + i, b2 = idx / NMOD, n = idx % NMOD; float v = P.b_ada[n];
            for (int kc = 0; kc < KCH; ++kc) v += modp[(size_t)(kc * BATCH + b2) * NMOD + n];
            modf[idx] = v; }
        __syncthreads();
        for (int r = wave; r < rows_per; r += NWAVES) norm_row<true, true>(P.x + (size_t)(row0 + r) * D, gsL, shL, H + (size_t)(row0 + r) * D, lane);
    }
#endif
    xcd_barrier(bar);

#if (PH_MASK >> 2) & 1
    {
        pg8::Gemm g{H, Win_t, D, D}; pg8::StaticOrder S; S.init(M, INW, D, D, G, bx);
        pg8::EpiIn E{P.b_in, AB, VG, KB, VB, SGA, SGB, stats, QSCALE};
        pg8::gemm_phase<pg8::EpiIn, pg8::StaticOrder, true, true>(L, g, S, E);
    }
#endif
    xcd_barrier(bar);

#if (PH_MASK >> 3) & 1
    for (int un = vcu; un < M / CHUNK; un += G) { gate_unit_valu(P, lds, un, tid); attn_unit_valu(P, lds, un, tid); }
#endif
    xcd_barrier(bar);

#if (PH_MASK >> 4) & 1
    {
        pg8::Gemm g{AB, Wab_t, 2 * D, D}; pg8::PairOrder S; S.init(M, D, D, 2 * D, G, bx);
        pg8::EpiMerge E{SGA, SGB, MG, (pg8::f32x4*)(ws + WS_H) + (size_t)bx * (32 * 512)};
        pg8::gemm_phase<pg8::EpiMerge, pg8::PairOrder, true, true>(L, g, S, E);
    }
#endif
    xcd_barrier(bar);

#if (PH_MASK >> 5) & 1
    {
        pg8::Gemm g{MG, Wout_t, D, D}; pg8::StaticOrder S; S.init(M, D, D, D, G, bx);
        pg8::EpiRes E{P.x, P.out, modf + 2 * D};
        pg8::gemm_phase<pg8::EpiRes, pg8::StaticOrder, true, true>(L, g, S, E);
    }
#endif
    xcd_barrier(bar);

#if (PH_MASK >> 6) & 1
    {
        const int rows_per = M / G, row0 = vcu * rows_per, b = row0 / SEQ;
        for (int col = tid; col < D; col += NWAVES * 64) { gsL[col] = P.g_mlp[col] * (1.0f + modf[(size_t)b * NMOD + 4 * D + col]); shL[col] = modf[(size_t)b * NMOD + 3 * D + col]; }
        __syncthreads();
        for (int r = wave; r < rows_per; r += NWAVES) norm_row<true, true>(P.out + (size_t)(row0 + r) * D, gsL, shL, H + (size_t)(row0 + r) * D, lane);
    }
#endif
    xcd_barrier(bar);

#if (PH_MASK >> 7) & 1
    {
        pg8::Gemm g{H, Wup_t, D, D}; pg8::StaticOrder S; S.init(M, FF, D, D, G, bx);
        pg8::EpiUp E{HB, FF};
        pg8::gemm_phase<pg8::EpiUp, pg8::StaticOrder, true, true>(L, g, S, E);
    }
#endif
    xcd_barrier(bar);

#if (PH_MASK >> 8) & 1
    {
        pg8::Gemm g{HB, Wdn_t, FF, FF}; pg8::StaticOrder S; S.init(M, D, FF, FF, G, bx);
        pg8::EpiRes E{P.out, P.out, modf + 5 * D};
        pg8::gemm_phase<pg8::EpiRes, pg8::StaticOrder, true, true>(L, g, S, E);
    }
#endif
    xcd_barrier(bar);

#if (PH_MASK >> 9) & 1
    {
        const int rows_per = M / G, row0 = vcu * rows_per;
        for (int col = tid; col < D; col += NWAVES * 64) gsL[col] = P.g_final[col];
        __syncthreads();
        for (int r = wave; r < rows_per; r += NWAVES) norm_row<false, false>(P.out + (size_t)(row0 + r) * D, gsL, shL, P.out + (size_t)(row0 + r) * D, lane);
    }
#endif
}

extern "C" void kernel_launch(void* const* d_in, const int* in_sizes, int n_in, void* d_out, int out_size, void* d_ws, size_t ws_size, hipStream_t stream) {
    static int grid = 0;
    if (grid == 0) {
        if (n_in != 19 || in_sizes[0] != M * D || out_size != M * D || ws_size < WS_END) { fprintf(stderr, "kernel_launch: unexpected shapes (n_in %d, in0 %d, out %d, ws %zu); nothing launched\n", n_in, n_in > 0 ? in_sizes[0] : -1, out_size, ws_size); grid = -1; return; }
        int dev = 0, cus = 0, per_cu = 0;
        if (hipGetDevice(&dev) != hipSuccess || hipDeviceGetAttribute(&cus, hipDeviceAttributeMultiprocessorCount, dev) != hipSuccess) { fprintf(stderr, "kernel_launch: device query failed\n"); grid = -1; return; }
        if (hipFuncSetAttribute((const void*)fwd_kernel, hipFuncAttributeMaxDynamicSharedMemorySize, LDS_BYTES) != hipSuccess) { fprintf(stderr, "kernel_launch: hipFuncSetAttribute failed\n"); grid = -1; return; }
        if (hipOccupancyMaxActiveBlocksPerMultiprocessor(&per_cu, (const void*)fwd_kernel, NWAVES * 64, LDS_BYTES) != hipSuccess || per_cu < 1) { fprintf(stderr, "kernel_launch: occupancy query reports %d workgroups per CU; nothing launched\n", per_cu); (void)hipGetLastError(); grid = -1; return; }
        grid = cus;
        if (grid != 256) { fprintf(stderr, "kernel_launch: %d CUs, built for 256; nothing launched\n", grid); grid = -1; return; }
    }
    if (grid < 0) return;
    if (hipMemsetAsync((char*)d_ws + WS_CTL, 0, CTL_ZERO_BYTES, stream) != hipSuccess) { fprintf(stderr, "kernel_launch: hipMemsetAsync failed\n"); return; }
    Args a{};
    for (int i = 0; i < 19; ++i) a.in[i] = (const float*)d_in[i];
    a.out = (float*)d_out; a.ws = (unsigned char*)d_ws;
    hipLaunchKernelGGL(fwd_kernel, dim3(grid), dim3(NWAVES * 64), LDS_BYTES, stream, a);
}
```

```cpp
#include <hip/hip_runtime.h>
#include <cstdio>
#include <cstdint>

namespace pg8 {
#define PG8_LAS __attribute__((address_space(3)))
typedef unsigned short bf16_t;
typedef short bf16x8 __attribute__((ext_vector_type(8)));
typedef float f32x4 __attribute__((ext_vector_type(4)));
typedef float f32x2 __attribute__((ext_vector_type(2)));
typedef unsigned u32x4 __attribute__((ext_vector_type(4)));
constexpr int BM = 256, BK = 64, HALF = 128, HTB = HALF * BK * 2  , STAGE_BYTES = 8 * HTB, NXCD = 8, WGM = 8;

__host__ __device__ __forceinline__ int lds_byte(int r, int c) { const int st = (r >> 4) * 2 + (c >> 5), rr = r & 15, cc = c & 31, ob = rr * 64 + cc * 2; return st * 1024 + (ob ^ (((ob >> 9) & 1) << 5)); }
__host__ __device__ __forceinline__ void stage_rc(int b, int& R, int& C) { const int st = b / 1024, sb = b % 1024, swz = sb ^ (((sb >> 9) & 1) << 5); R = (st >> 1) * 16 + swz / 64; C = (st & 1) * 32 + (swz % 64) / 2; }
__host__ __device__ __forceinline__ int perm32(int rho) { const int n = rho >> 4, i = rho & 15; return 8 * (i >> 2) + 4 * n + (i & 3); }

struct Unit { int pm, pn, sub; size_t aoff, boff; };
struct Gemm { const bf16_t* A; const bf16_t* Bt; int lda, K; };

struct StaticOrder {
    int nM, nN, nwg, G, c, lda, K;
    __host__ __device__ void init(int M, int N, int K_, int lda_, int G_, int c_) { nM = M / BM; nN = N / BM; nwg = nM * nN; G = G_; c = c_; lda = lda_; K = K_; }
    __host__ __device__ bool next(int i, Unit& u) const {
        const long L = (long)i * G + c; if (L >= nwg) return false;
        int wgid = (int)L; { const int q = nwg / NXCD, r = nwg % NXCD, xcd = wgid % NXCD, off = wgid / NXCD; wgid = (xcd < r ? xcd * (q + 1) : r * (q + 1) + (xcd - r) * q) + off; }
        const int nig = WGM * nN, gid = wgid / nig, fm = gid * WGM, gsz = (nM - fm) < WGM ? (nM - fm) : WGM;
        u.pm = fm + ((wgid % nig) % gsz); u.pn = (wgid % nig) / gsz; u.sub = 0;
        u.aoff = (size_t)u.pm * BM * lda * 2; u.boff = (size_t)u.pn * BM * K * 2; return true;
    }
    __device__ __forceinline__ void a_ready(const Unit&) const {}
    __device__ __forceinline__ void done(const Unit&) const {}
};
struct PairOrder {
    StaticOrder S; int N;
    __host__ __device__ void init(int M, int N_, int K_, int lda_, int G_, int c_) { S.init(M, N_, K_, lda_, G_, c_); N = N_; }
    __host__ __device__ bool next(int i, Unit& u) const {
        if (!S.next(i >> 1, u)) return false;
        u.sub = i & 1; if (u.sub) { u.aoff += (size_t)S.K * 2; u.boff += (size_t)N * S.K * 2; } return true;
    }
    __device__ __forceinline__ void a_ready(const Unit&) const {}
    __device__ __forceinline__ void done(const Unit&) const {}
};

__device__ __forceinline__ unsigned cvt_pk_bf16(float lo, float hi) { unsigned r; asm volatile("v_cvt_pk_bf16_f32 %0, %1, %2" : "=v"(r) : "v"(lo), "v"(hi)); return r; }
__device__ __forceinline__ float bf_lo(unsigned w) { return __uint_as_float(w << 16); }
__device__ __forceinline__ float bf_hi(unsigned w) { return __uint_as_float(w & 0xffff0000u); }
__device__ __forceinline__ float gelu_tanh(float x) { const float y = x * (1.0f + 0.044715f * x * x); const float e = __builtin_amdgcn_exp2f(-2.3022082f * y); return x * __builtin_amdgcn_rcpf(1.0f + e); }
__device__ __forceinline__ float sigmoid_f(float x) { const float e = __builtin_amdgcn_exp2f(-1.44269504f * x); return __builtin_amdgcn_rcpf(1.0f + e); }

struct EpiIn {
    static constexpr bool PERM = true, AFTER_DRAIN = false;
    const float* bias; bf16_t *AB, *VG, *KB, *VB, *SGA, *SGB; float* stats; float qscale;
    __device__ __forceinline__ void operator()(const f32x4 (&acc)[2][2][4][2], const Unit& u, int wr, int wc, int fr, int fq) const {
        const int pn = u.pn; int kind, ldo, colt; bf16_t* base;
        if (pn < 4)        { kind = 0; base = AB;        ldo = 2048; colt = pn * BM; }
        else if (pn < 8)   { kind = 1; base = VG;        ldo = 1024; colt = (pn - 4) * BM; }
        else if (pn < 12)  { kind = 2; base = AB + 1024; ldo = 2048; colt = (pn - 8) * BM; }
        else if (pn == 12) { kind = 3; base = KB;        ldo = 256;  colt = 0; }
        else if (pn == 13) { kind = 3; base = VB;        ldo = 256;  colt = 0; }
        else if (pn < 18)  { kind = 4; base = SGA;       ldo = 1024; colt = (pn - 14) * BM; }
        else               { kind = 4; base = SGB;       ldo = 1024; colt = (pn - 18) * BM; }
        const int row0 = u.pm * BM + wr * 64 + fr;
        const int col0 = colt + wc * 32 + 8 * fq, bcol0 = pn * BM + wc * 32 + 8 * fq;
        f32x4 bv[2][2];
#pragma unroll
        for (int bj = 0; bj < 2; ++bj)
#pragma unroll
            for (int n = 0; n < 2; ++n) bv[bj][n] = *(const f32x4*)(bias + bcol0 + bj * HALF + 4 * n);
#pragma unroll
        for (int ai = 0; ai < 2; ++ai)
#pragma unroll
            for (int m = 0; m < 4; ++m) { const int row = row0 + ai * HALF + m * 16; bf16_t* rowp = base + (size_t)row * ldo + col0; float s1 = 0.f, s2 = 0.f;
#pragma unroll
                for (int bj = 0; bj < 2; ++bj) { f32x4 v0 = acc[ai][bj][m][0] + bv[bj][0], v1 = acc[ai][bj][m][1] + bv[bj][1];
                    if (kind <= 1) {
#pragma unroll
                        for (int e = 0; e < 4; ++e) { v0[e] = gelu_tanh(v0[e]); v1[e] = gelu_tanh(v1[e]); }
                        if (kind == 1) {
#pragma unroll
                            for (int e = 0; e < 4; ++e) { s1 += v0[e] + v1[e]; s2 += v0[e] * v0[e] + v1[e] * v1[e]; } }
                    } else if (kind == 2) { v0 = v0 * qscale; v1 = v1 * qscale; }
                    else if (kind == 4) {
#pragma unroll
                        for (int e = 0; e < 4; ++e) { v0[e] = sigmoid_f(v0[e]); v1[e] = sigmoid_f(v1[e]); } }
                    u32x4 w; w.x = cvt_pk_bf16(v0[0], v0[1]); w.y = cvt_pk_bf16(v0[2], v0[3]); w.z = cvt_pk_bf16(v1[0], v1[1]); w.w = cvt_pk_bf16(v1[2], v1[3]);
                    *(u32x4*)(rowp + bj * HALF) = w; }
                if (kind == 1) { s1 += __shfl_xor(s1, 16); s2 += __shfl_xor(s2, 16); s1 += __shfl_xor(s1, 32); s2 += __shfl_xor(s2, 32);
                    if (fq == 0) *(f32x2*)(stats + ((size_t)row * 16 + (pn - 4) * 4 + wc) * 2) = (f32x2){s1, s2}; } }
    }
};
struct EpiMerge {
    static constexpr bool PERM = true, AFTER_DRAIN = false;
    const bf16_t *SGA, *SGB; bf16_t* MG; f32x4* scratch;
    __device__ __forceinline__ void operator()(const f32x4 (&acc)[2][2][4][2], const Unit& u, int wr, int wc, int fr, int fq) const {
        const int row0 = u.pm * BM + wr * 64 + fr, col0 = u.pn * BM + wc * 32 + 8 * fq, tid = (wr * 4 + wc) * 64 + fq * 16 + fr;
        const bf16_t* Gt = u.sub ? SGB : SGA;
        f32x4* sp = scratch + tid;
#pragma unroll
        for (int ai = 0; ai < 2; ++ai)
#pragma unroll
            for (int m = 0; m < 4; ++m) { const size_t ro = (size_t)(row0 + ai * HALF + m * 16) * 1024 + col0;
#pragma unroll
                for (int bj = 0; bj < 2; ++bj) { const u32x4 gw = *(const u32x4*)(Gt + ro + bj * HALF);
                    f32x4 v0 = acc[ai][bj][m][0] * (f32x4){bf_lo(gw.x), bf_hi(gw.x), bf_lo(gw.y), bf_hi(gw.y)};
                    f32x4 v1 = acc[ai][bj][m][1] * (f32x4){bf_lo(gw.z), bf_hi(gw.z), bf_lo(gw.w), bf_hi(gw.w)};
                    if (u.sub == 0) { sp[0] = v0; sp[512] = v1; }
                    else { v0 = v0 + sp[0]; v1 = v1 + sp[512];
                        u32x4 w; w.x = cvt_pk_bf16(v0[0], v0[1]); w.y = cvt_pk_bf16(v0[2], v0[3]); w.z = cvt_pk_bf16(v1[0], v1[1]); w.w = cvt_pk_bf16(v1[2], v1[3]);
                        *(u32x4*)(MG + ro + bj * HALF) = w; }
                    sp += 1024; asm volatile("" : "+v"(sp)); }
                asm volatile("" ::: "memory"); }
    }
};
struct EpiRes {
    static constexpr bool PERM = false, AFTER_DRAIN = false;
    const float* base; float* out; const float* gate;
    __device__ __forceinline__ void operator()(const f32x4 (&acc)[2][2][4][2], const Unit& u, int wr, int wc, int fr, int fq) const {
        const int row0 = u.pm * BM + wr * 64 + fr, col0 = u.pn * BM + wc * 32 + 4 * fq;
        const float* gt = gate + (size_t)(u.pm >> 4) * 6144;
        f32x4 gv[2][2];
#pragma unroll
        for (int bj = 0; bj < 2; ++bj)
#pragma unroll
            for (int n = 0; n < 2; ++n) gv[bj][n] = *(const f32x4*)(gt + col0 + bj * HALF + n * 16);
#pragma unroll
        for (int ai = 0; ai < 2; ++ai)
#pragma unroll
            for (int m = 0; m < 4; ++m) { const size_t off = (size_t)(row0 + ai * HALF + m * 16) * 1024 + col0;
#pragma unroll
                for (int bj = 0; bj < 2; ++bj)
#pragma unroll
                    for (int n = 0; n < 2; ++n) { const f32x4 bs = *(const f32x4*)(base + off + bj * HALF + n * 16); *(f32x4*)(out + off + bj * HALF + n * 16) = bs + gv[bj][n] * acc[ai][bj][m][n]; }
                if (m & 1) asm volatile("" ::: "memory"); }
    }
};
struct EpiUp {
    static constexpr bool PERM = true, AFTER_DRAIN = false;
    bf16_t* O; int ldc;
    __device__ __forceinline__ void operator()(const f32x4 (&acc)[2][2][4][2], const Unit& u, int wr, int wc, int fr, int fq) const {
        const int row0 = u.pm * BM + wr * 64 + fr, col0 = u.pn * BM + wc * 32 + 8 * fq;
#pragma unroll
        for (int ai = 0; ai < 2; ++ai)
#pragma unroll
            for (int m = 0; m < 4; ++m) { bf16_t* rowp = O + (size_t)(row0 + ai * HALF + m * 16) * ldc + col0;
#pragma unroll
                for (int bj = 0; bj < 2; ++bj) { f32x4 v0 = acc[ai][bj][m][0], v1 = acc[ai][bj][m][1];
#pragma unroll
                    for (int e = 0; e < 4; ++e) { const float a = fmaxf(v0[e], 0.f), b = fmaxf(v1[e], 0.f); v0[e] = a * a; v1[e] = b * b; }
                    u32x4 w; w.x = cvt_pk_bf16(v0[0], v0[1]); w.y = cvt_pk_bf16(v0[2], v0[3]); w.z = cvt_pk_bf16(v1[0], v1[1]); w.w = cvt_pk_bf16(v1[2], v1[3]);
                    *(u32x4*)(rowp + bj * HALF) = w; } }
    }
};

template <class Epi, class Sched, bool ALIGN_EPI = false, bool SP2 = false>
__device__ __forceinline__ void gemm_phase(PG8_LAS unsigned char* lds, const Gemm g, const Sched& S, const Epi& E, const int tid) {
    const int wid = __builtin_amdgcn_readfirstlane(tid >> 6), lane = tid & 63, wr = wid >> 2, wc = wid & 3, fr = lane & 15, fq = lane >> 4;
    const int K = g.K, nt = K / BK, lda = g.lda;
    unsigned voffA[2], voffB[2];
#pragma unroll
    for (int i = 0; i < 2; ++i) { int R, C; stage_rc(tid * 16 + i * 8192, R, C); const int Rb = Epi::PERM ? ((R & ~31) + perm32(R & 31)) : R;
        voffA[i] = (unsigned)(R * lda + C) * 2u; voffB[i] = (unsigned)(Rb * K + C) * 2u; }
    const size_t kstep = (size_t)(BK * 2);
    const size_t hstep = (size_t)HALF * K * 2, hstepA = (size_t)HALF * lda * 2;
    const size_t tstep = 2 * hstep;
    const unsigned ldsw = (unsigned)wid * 1024u;
    const int aoff = lds_byte(wr * 64 + fr, fq * 8), boff = lds_byte(wc * 32 + fr, fq * 8);
#define PG8_SA(b, h) (((b) * 2 + (h)) * HTB)
#define PG8_SB(b, h) ((4 + (b) * 2 + (h)) * HTB)
#define PG8_STAGE(bufoff, gbase, voff) do { _Pragma("unroll") for (int _i = 0; _i < 2; ++_i) \
        __builtin_amdgcn_global_load_lds((const unsigned*)((const char*)(gbase) + (voff)[_i]), (PG8_LAS unsigned*)(lds + (bufoff) + ldsw + _i * 8192), 16, 0, 0); } while (0)
#define PG8_LDA(dst, b, h) do { _Pragma("unroll") for (int m = 0; m < 4; ++m) _Pragma("unroll") for (int k = 0; k < 2; ++k) dst[m][k] = *(const PG8_LAS bf16x8*)(lds + PG8_SA(b, h) + aoff + m * 2048 + k * 1024); } while (0)
#define PG8_LDB(dst, b, h) do { _Pragma("unroll") for (int n = 0; n < 2; ++n) _Pragma("unroll") for (int k = 0; k < 2; ++k) dst[n][k] = *(const PG8_LAS bf16x8*)(lds + PG8_SB(b, h) + boff + n * 2048 + k * 1024); } while (0)
#define PG8_MMA(ai, bj, At, Bt) do { __builtin_amdgcn_s_setprio(1); _Pragma("unroll") for (int m = 0; m < 4; ++m) _Pragma("unroll") for (int n = 0; n < 2; ++n) _Pragma("unroll") for (int k = 0; k < 2; ++k) \
        acc[ai][bj][m][n] = __builtin_amdgcn_mfma_f32_16x16x32_bf16(Bt[n][k], At[m][k], acc[ai][bj][m][n], 0, 0, 0); __builtin_amdgcn_s_setprio(0); } while (0)
#define PG8_WAIT_V(n) asm volatile("s_waitcnt vmcnt(" #n ")" ::: "memory")
#define PG8_WAIT_L(n) asm volatile("s_waitcnt lgkmcnt(" #n ")" ::: "memory")
#define PG8_BAR __builtin_amdgcn_s_barrier()
#define PG8_SCHED __builtin_amdgcn_sched_barrier(0)
    Unit cur, nxt; int ui = 0;
    if (!S.next(0, cur)) return;
    f32x4 acc[2][2][4][2];
#pragma unroll
    for (int a = 0; a < 2; ++a)
#pragma unroll
        for (int b = 0; b < 2; ++b)
#pragma unroll
            for (int m = 0; m < 4; ++m)
#pragma unroll
                for (int n = 0; n < 2; ++n) acc[a][b][m][n] = (f32x4){0.f, 0.f, 0.f, 0.f};
    bf16x8 At[4][2], B0[2][2], B1[2][2];
    const char* cA = (const char*)g.A + cur.aoff; const char* cB = (const char*)g.Bt + cur.boff;
    S.a_ready(cur);
    if constexpr (SP2) {
        PG8_STAGE(PG8_SB(0, 0), cB, voffB); PG8_STAGE(PG8_SB(0, 1), cB + hstep, voffB); PG8_STAGE(PG8_SA(0, 0), cA, voffA); PG8_STAGE(PG8_SA(0, 1), cA + hstepA, voffA);
        if (wr == 1) PG8_BAR;
        PG8_WAIT_V(2); PG8_BAR;
        PG8_STAGE(PG8_SB(1, 0), cB + kstep, voffB); PG8_STAGE(PG8_SA(1, 0), cA + kstep, voffA); PG8_STAGE(PG8_SB(1, 1), cB + hstep + kstep, voffB);
        PG8_WAIT_V(6); PG8_BAR;
    } else {
        PG8_STAGE(PG8_SB(0, 0), cB, voffB); PG8_STAGE(PG8_SA(0, 0), cA, voffA); PG8_STAGE(PG8_SB(0, 1), cB + hstep, voffB); PG8_STAGE(PG8_SA(0, 1), cA + hstepA, voffA);
        if (wr == 1) PG8_BAR;
        PG8_WAIT_V(4); PG8_BAR;
        PG8_STAGE(PG8_SB(1, 0), cB + kstep, voffB); PG8_STAGE(PG8_SA(1, 0), cA + kstep, voffA); PG8_STAGE(PG8_SB(1, 1), cB + hstep + kstep, voffB);
        PG8_WAIT_V(6); PG8_BAR;
    }
    for (;;) {
        const bool has_next = S.next(ui + 1, nxt);
        const char* nA = has_next ? (const char*)g.A + nxt.aoff : cA; const char* nB = has_next ? (const char*)g.Bt + nxt.boff : cB;
        for (int t = 0; t < nt; t += 2) {
            const bool last = (t == nt - 2);
            const char* a1 = cA + (size_t)(t + 1) * kstep;
            const char* a2 = last ? nA : cA + (size_t)(t + 2) * kstep; const char* b2 = last ? nB : cB + (size_t)(t + 2) * kstep;
            const char* a3 = a2 + kstep; const char* b3 = b2 + kstep;
            if (last && has_next) S.a_ready(nxt);
            if constexpr (SP2) {
            PG8_LDB(B0, 0, 0); PG8_LDB(B1, 0, 1); PG8_SCHED; PG8_LDA(At, 0, 0); PG8_STAGE(PG8_SA(1, 1), a1 + hstepA, voffA);
            PG8_WAIT_V(8); PG8_WAIT_L(0); PG8_BAR; PG8_MMA(0, 0, At, B0); PG8_MMA(0, 1, At, B1); PG8_BAR; PG8_SCHED;
            PG8_LDA(At, 0, 1); PG8_STAGE(PG8_SB(0, 0), b2, voffB); PG8_STAGE(PG8_SB(0, 1), b2 + hstep, voffB); PG8_STAGE(PG8_SA(0, 0), a2, voffA);
            PG8_WAIT_V(8); PG8_WAIT_L(0); PG8_BAR; PG8_MMA(1, 0, At, B0); PG8_MMA(1, 1, At, B1); PG8_BAR; PG8_SCHED;
            PG8_LDB(B0, 1, 0); PG8_LDB(B1, 1, 1); PG8_SCHED; PG8_LDA(At, 1, 0); PG8_STAGE(PG8_SA(0, 1), a2 + hstepA, voffA);
            PG8_WAIT_V(8); PG8_WAIT_L(0); PG8_BAR; PG8_MMA(0, 0, At, B0); PG8_MMA(0, 1, At, B1); PG8_BAR; PG8_SCHED;
            PG8_LDA(At, 1, 1); PG8_STAGE(PG8_SB(1, 0), b3, voffB); PG8_STAGE(PG8_SB(1, 1), b3 + hstep, voffB); PG8_STAGE(PG8_SA(1, 0), a3, voffA);
            PG8_WAIT_V(8); PG8_WAIT_L(0); PG8_BAR; PG8_MMA(1, 0, At, B0); PG8_MMA(1, 1, At, B1); PG8_BAR; PG8_SCHED;
            } else {
            PG8_LDB(B0, 0, 0); PG8_SCHED; PG8_LDA(At, 0, 0); PG8_STAGE(PG8_SA(1, 1), a1 + hstepA, voffA);
            PG8_WAIT_L(8); PG8_BAR; PG8_WAIT_L(0); PG8_MMA(0, 0, At, B0); PG8_BAR; PG8_SCHED;
            PG8_LDB(B1, 0, 1); PG8_STAGE(PG8_SB(0, 0), b2, voffB);
            PG8_BAR; PG8_WAIT_L(0); PG8_MMA(0, 1, At, B1); PG8_BAR;
            PG8_LDA(At, 0, 1); PG8_STAGE(PG8_SA(0, 0), a2, voffA);
            PG8_BAR; PG8_WAIT_L(0); PG8_MMA(1, 0, At, B0); PG8_BAR; PG8_SCHED;
            PG8_STAGE(PG8_SB(0, 1), b2 + hstep, voffB);
            PG8_WAIT_V(6); PG8_BAR; PG8_MMA(1, 1, At, B1); PG8_BAR;
            PG8_LDB(B0, 1, 0); PG8_SCHED; PG8_LDA(At, 1, 0); PG8_STAGE(PG8_SA(0, 1), a2 + hstepA, voffA);
            PG8_WAIT_L(8); PG8_BAR; PG8_WAIT_L(0); PG8_MMA(0, 0, At, B0); PG8_BAR; PG8_SCHED;
            PG8_LDB(B1, 1, 1); PG8_STAGE(PG8_SB(1, 0), b3, voffB);
            PG8_BAR; PG8_WAIT_L(0); PG8_MMA(0, 1, At, B1); PG8_BAR;
            PG8_LDA(At, 1, 1); PG8_STAGE(PG8_SA(1, 0), a3, voffA);
            PG8_BAR; PG8_WAIT_L(0); PG8_MMA(1, 0, At, B0); PG8_BAR; PG8_SCHED;
            PG8_STAGE(PG8_SB(1, 1), b3 + hstep, voffB);
            PG8_WAIT_V(6); PG8_BAR; PG8_MMA(1, 1, At, B1); PG8_BAR;
            }
        }
        if constexpr (ALIGN_EPI) { if (wr == 0) PG8_BAR; }
        if constexpr (!Epi::AFTER_DRAIN) { E(acc, cur, wr, wc, fr, fq); S.done(cur); }
        if (!has_next) break;
#pragma unroll
        for (int a = 0; a < 2; ++a)
#pragma unroll
            for (int b = 0; b < 2; ++b)
#pragma unroll
                for (int m = 0; m < 4; ++m)
#pragma unroll
                    for (int n = 0; n < 2; ++n) acc[a][b][m][n] = (f32x4){0.f, 0.f, 0.f, 0.f};
        cur = nxt; cA = nA; cB = nB; ++ui;
        if constexpr (ALIGN_EPI) { if (wr == 1) PG8_BAR; }
    }
    PG8_WAIT_V(0);
    if constexpr (!ALIGN_EPI) { if (wr == 0) PG8_BAR; }
    PG8_BAR;
    if constexpr (Epi::AFTER_DRAIN) { E.fused(acc, cur, wr, wc, fr, fq, lds, wid, lane); S.done(cur); }
#undef PG8_SA
#undef PG8_SB
#undef PG8_STAGE
#undef PG8_LDA
#undef PG8_LDB
#undef PG8_MMA
#undef PG8_WAIT_V
#undef PG8_WAIT_L
#undef PG8_BAR
#undef PG8_SCHED
}
}

#define GAS __attribute__((address_space(1)))
#define LAS __attribute__((address_space(3)))
typedef unsigned short bf16;
typedef unsigned v4u __attribute__((ext_vector_type(4)));
typedef float f32x4 __attribute__((ext_vector_type(4)));
typedef short bf16x8 __attribute__((ext_vector_type(8)));
typedef GAS unsigned gu32;
typedef GAS unsigned long long gu64;
#define RLX_AGENT __ATOMIC_RELAXED, __HIP_MEMORY_SCOPE_AGENT
#define LDS_WAIT() asm volatile("s_waitcnt lgkmcnt(0)" ::: "memory")
#define VM_WAIT() asm volatile("s_waitcnt vmcnt(0)" ::: "memory")
__device__ __forceinline__ unsigned long long rt() { return __builtin_amdgcn_s_memrealtime(); }
__device__ __forceinline__ unsigned f2bf(float f) { unsigned u = __builtin_bit_cast(unsigned, f); return (u + 0x7fffu + ((u >> 16) & 1u)) >> 16; }
__device__ __forceinline__ unsigned pk2(float lo, float hi) { return f2bf(lo) | (f2bf(hi) << 16); }

#define XB_TMO      128
#define XB_XCNT(j)  (256  + 64 * (j))
#define XB_XSUB(j)  (1280 + 64 * (j))
#define XB_XGEN(j)  (2304 + 64 * (j))
#define XB_TOP      3328
#define XB_TOPGEN   3392
#define XCD_BAR_WORDS 3456
#define XB_SPIN_CAP (1u << 18)

__device__ __forceinline__ unsigned xb_ld(unsigned* p)              { return __hip_atomic_load(p, __ATOMIC_RELAXED, __HIP_MEMORY_SCOPE_AGENT); }
__device__ __forceinline__ unsigned xb_add(unsigned* p, unsigned v) { return __hip_atomic_fetch_add(p, v, __ATOMIC_RELAXED, __HIP_MEMORY_SCOPE_AGENT); }
__device__ __forceinline__ unsigned xb_xcc_id() { return (unsigned)__builtin_amdgcn_s_getreg((3 << 11) | 20) & 0xFu; }
#define XB_SPIN(cond, bar) do { unsigned _sp = 0; while (cond) { __builtin_amdgcn_s_sleep(1); \
    if ((++_sp & 255u) == 0u) { if (xb_ld(&(bar)[XB_TMO])) break; if (_sp > XB_SPIN_CAP) { atomicAdd(&(bar)[XB_TMO], 1u); break; } } } } while (0)

struct XcdBarrier {
    unsigned* bar; unsigned x;
    volatile LAS unsigned* st;
};

__device__ __forceinline__ XcdBarrier xcd_barrier_post(unsigned* bar, volatile LAS unsigned* st) {
    XcdBarrier b; b.bar = bar; b.x = xb_xcc_id(); b.st = st;
    if (threadIdx.x == 0) (void)xb_add(&bar[XB_XCNT(b.x)], 1u);
    return b;
}
__device__ __forceinline__ void xcd_barrier_complete(unsigned* bar, unsigned x, unsigned& nloc, unsigned& nx) {
    const unsigned G = gridDim.x * gridDim.y * gridDim.z;
    unsigned sum, cnt, mine, sp = 0u;
    for (;;) {
        sum = 0u; cnt = 0u; mine = 0u;
#pragma unroll
        for (unsigned j = 0; j < 16; ++j) { const unsigned c = xb_ld(&bar[XB_XCNT(j)]); sum += c; cnt += (c > 0u) ? 1u : 0u; mine = (j == x) ? c : mine; }
        if (sum == G) break;
        __builtin_amdgcn_s_sleep(1);
        if ((++sp & 255u) == 0u) { if (xb_ld(&bar[XB_TMO])) break; if (sp > XB_SPIN_CAP) { atomicAdd(&bar[XB_TMO], 1u); break; } }
    }
    nloc = mine > 0u ? mine : 1u; nx = cnt > 0u ? cnt : 1u;
}

__device__ __forceinline__ void xcd_barrier(const XcdBarrier& b) {
    asm volatile("s_waitcnt vmcnt(0)" ::: "memory");
    __syncthreads();
    if (threadIdx.x == 0) {
        unsigned* bar = b.bar;
        __builtin_amdgcn_s_waitcnt(0);
        unsigned nloc = b.st[0], nx = b.st[1];
        if (nloc == 0u) { xcd_barrier_complete(bar, b.x, nloc, nx); b.st[0] = nloc; b.st[1] = nx; }
        const unsigned old = xb_add(&bar[XB_XSUB(b.x)], 1u);
        const unsigned gen = old / nloc;
        if (old + 1u == (gen + 1u) * nloc) {
            __builtin_amdgcn_fence(__ATOMIC_RELEASE, "agent");
            asm volatile("s_waitcnt vmcnt(0)" ::: "memory");
            const unsigned og = xb_add(&bar[XB_TOP], 1u);
            const unsigned tg = og / nx;
            if (og + 1u == (tg + 1u) * nx) xb_add(&bar[XB_TOPGEN], 1u);
            else XB_SPIN(xb_ld(&bar[XB_TOPGEN]) == tg, bar);
            __builtin_amdgcn_fence(__ATOMIC_ACQUIRE, "agent");
            xb_add(&bar[XB_XGEN(b.x)], 1u);
            asm volatile("s_waitcnt vmcnt(0)" ::: "memory");
        } else {
            XB_SPIN(xb_ld(&bar[XB_XGEN(b.x)]) == gen, bar);
            __builtin_amdgcn_fence(__ATOMIC_ACQUIRE, "agent");
            asm volatile("s_waitcnt vmcnt(0)" ::: "memory");
        }
    }
    __syncthreads();
}

constexpr int NWAVES = 8;
constexpr int BATCH = 8, SEQ = 4096, D = 1024, FF = 4096, M = BATCH * SEQ;
constexpr int INW = 5632, NMOD = 6 * D, CHUNK = 128, NQH = 16, NKVH = 4, HD = 64;
constexpr float EPS = 1e-6f, LOG2E = 1.4426950408889634f;
constexpr float QSCALE = 0.125f * LOG2E;
constexpr int KCH = 16;

constexpr size_t MiB = 1u << 20;
constexpr size_t WS_CTL = 0, CTL_ZERO_BYTES = 1 * MiB;
constexpr size_t WS_MODP = 1 * MiB;
constexpr size_t WS_MODF = 4 * MiB;
constexpr size_t WS_STATS = 5 * MiB;
constexpr size_t WS_WIN = 10 * MiB, WS_WAB = 21 * MiB, WS_WOUT = 25 * MiB, WS_WUP = 27 * MiB, WS_WDN = 35 * MiB;
constexpr size_t WS_H = 48 * MiB;
constexpr size_t WS_AB = 112 * MiB;
constexpr size_t WS_VG = 240 * MiB;
constexpr size_t WS_KB = 304 * MiB, WS_VB = 320 * MiB;
constexpr size_t WS_SGA = 336 * MiB, WS_SGB = 400 * MiB;
constexpr size_t WS_HB = 112 * MiB;
constexpr size_t WS_END = 464 * MiB;
constexpr int CW_TMO = 0, CW_BAR = 4096;

constexpr int RING_BYTES = 131072;
constexpr int LDSCTL_OFF = RING_BYTES;
constexpr int BARST_OFF = LDSCTL_OFF + 64;
constexpr int XTRA_OFF = LDSCTL_OFF + 1024;
constexpr int LDS_BYTES = 147456;

__device__ __forceinline__ float wave_sum(float v) {
#pragma unroll
    for (int o = 1; o < 64; o <<= 1) v += __shfl_xor(v, o);
    return v;
}
__device__ __forceinline__ float bf2f(bf16 h) { return __uint_as_float((unsigned)h << 16); }

__device__ __forceinline__ void p0_transpose_item(const float* W, int K, int N, bf16* WT, int row_off, LAS float* scr, int item, int lane) {
    const int nblk = N / 32, kb = item / nblk, nb = item % nblk, k0 = 64 * kb, n0 = 32 * nb;
#pragma unroll 8
    for (int i = 0; i < 32; ++i) { const int kk = 2 * i + (lane >> 5); scr[kk * 33 + (lane & 31)] = W[(size_t)(k0 + kk) * N + n0 + (lane & 31)]; }
    LDS_WAIT(); asm volatile("" ::: "memory");
    const int c = lane & 7;
#pragma unroll
    for (int j = 0; j < 4; ++j) { const int n = (lane >> 3) + 8 * j; const LAS float* s = scr + (8 * c) * 33 + n;
        v4u o; o.x = pk2(s[0 * 33], s[1 * 33]); o.y = pk2(s[2 * 33], s[3 * 33]); o.z = pk2(s[4 * 33], s[5 * 33]); o.w = pk2(s[6 * 33], s[7 * 33]);
        *(GAS v4u*)(WT + (size_t)(row_off + n0 + n) * K + k0 + 8 * c) = o; }
    LDS_WAIT(); asm volatile("" ::: "memory");
}

struct Ptrs {
    const float *x, *c, *w_ada, *b_ada, *g_mix, *w_in, *b_in, *ln_g, *ln_b, *gm_ws, *gm_bs, *sinks, *w_a, *w_b, *w_out, *g_mlp, *w_up, *w_down, *g_final;
    float* out; unsigned char* ws;
};

__device__ __forceinline__ void p0_prologue(const Ptrs& P, LAS unsigned char* lds, int vcu, int G, int tid, int lane, int wave) {
    LAS float* sl = (LAS float*)(lds + 8 * 8704);
    for (int i = tid; i < BATCH * D; i += NWAVES * 64) { const float v = P.c[i]; sl[i] = v / (1.0f + __expf(-v)); }
    __syncthreads();
    LAS float* scr = (LAS float*)(lds + wave * 8704);
    float* modp = (float*)(P.ws + WS_MODP);
    const int gw = vcu * NWAVES + wave, NGW = G * NWAVES;
    constexpr int I_MOD = (NMOD / 64) * KCH;
    constexpr int I_IN = (D / 64) * (INW / 32), I_SQ = (D / 64) * (D / 32), I_UP = (D / 64) * (FF / 32), I_DN = (FF / 64) * (D / 32);
    constexpr int NITEMS = I_MOD + I_IN + 3 * I_SQ + I_UP + I_DN;
    bf16* Win_t = (bf16*)(P.ws + WS_WIN); bf16* Wab_t = (bf16*)(P.ws + WS_WAB); bf16* Wout_t = (bf16*)(P.ws + WS_WOUT); bf16* Wup_t = (bf16*)(P.ws + WS_WUP); bf16* Wdn_t = (bf16*)(P.ws + WS_WDN);
    for (int it = gw; it < NITEMS; it += NGW) {
        int r = it;
        if (r < I_MOD) {
            const int nb = r % (NMOD / 64), kc = r / (NMOD / 64), n = nb * 64 + lane, kq = D / KCH;
            float a[BATCH];
#pragma unroll
            for (int b = 0; b < BATCH; ++b) a[b] = 0.f;
            const float* wp = P.w_ada + (size_t)(kc * kq) * NMOD + n;
#pragma unroll 8
            for (int k = 0; k < kq; ++k) { const float w = wp[(size_t)k * NMOD];
#pragma unroll
                for (int b = 0; b < BATCH; ++b) a[b] += sl[b * D + kc * kq + k] * w; }
#pragma unroll
            for (int b = 0; b < BATCH; ++b) modp[(size_t)(kc * BATCH + b) * NMOD + n] = a[b];
            continue; }
        r -= I_MOD;
        if (r < I_IN) { p0_transpose_item(P.w_in, D, INW, Win_t, 0, scr, r, lane); continue; } r -= I_IN;
        if (r < I_SQ) { p0_transpose_item(P.w_a, D, D, Wab_t, 0, scr, r, lane); continue; } r -= I_SQ;
        if (r < I_SQ) { p0_transpose_item(P.w_b, D, D, Wab_t, D, scr, r, lane); continue; } r -= I_SQ;
        if (r < I_SQ) { p0_transpose_item(P.w_out, D, D, Wout_t, 0, scr, r, lane); continue; } r -= I_SQ;
        if (r < I_UP) { p0_transpose_item(P.w_up, D, FF, Wup_t, 0, scr, r, lane); continue; } r -= I_UP;
        p0_transpose_item(P.w_down, FF, D, Wdn_t, 0, scr, r, lane);
    }
}

template <bool OUT_BF16, bool HAS_SH>
__device__ __forceinline__ void norm_row(const float* src, const LAS float* gs, const LAS float* sh, void* dst, int lane) {
    const GAS f32x4* xr = (const GAS f32x4*)src + lane;
    f32x4 v[4]; float s = 0.f;
#pragma unroll
    for (int j = 0; j < 4; ++j) { v[j] = xr[64 * j]; s += (v[j].x * v[j].x + v[j].y * v[j].y) + (v[j].z * v[j].z + v[j].w * v[j].w); }
    const float rstd = 1.0f / sqrtf(wave_sum(s) * (1.0f / D) + EPS);
#pragma unroll
    for (int j = 0; j < 4; ++j) { const f32x4 g = *(const LAS f32x4*)(gs + 4 * lane + 256 * j); f32x4 o = v[j] * rstd * g;
        if (HAS_SH) o = o + *(const LAS f32x4*)(sh + 4 * lane + 256 * j);
        if (OUT_BF16) ((GAS unsigned long long*)dst)[lane + 64 * j] = (unsigned long long)pk2(o.x, o.y) | ((unsigned long long)pk2(o.z, o.w) << 32);
        else ((GAS f32x4*)dst)[lane + 64 * j] = o; }
}

__device__ __forceinline__ void gate_unit_valu(const Ptrs& P, unsigned char* lds, int un, int tid) {
    float* Wt = (float*)lds; float* Vt = (float*)(lds + 65536);
    float* mu = (float*)(lds + XTRA_OFF); float* rs = mu + 128;
    const float* stats = (const float*)(P.ws + WS_STATS); const bf16* VG = (const bf16*)(P.ws + WS_VG); bf16* AB = (bf16*)(P.ws + WS_AB);
    const size_t R0 = (size_t)un * CHUNK;
    if (tid < 128) { float s1 = 0.f, s2 = 0.f; const float* sp = stats + (R0 + tid) * 32;
        for (int p = 0; p < 16; ++p) { s1 += sp[2 * p]; s2 += sp[2 * p + 1]; }
        const float mean = s1 * (1.0f / D), var = fmaxf(s2 * (1.0f / D) - mean * mean, 0.f); mu[tid] = mean; rs[tid] = 1.0f / sqrtf(var + EPS); }
    __syncthreads();
    for (int g = 0; g < 8; ++g) {
        for (int i = tid; i < 16384; i += 512) { const int t = i >> 7, s = i & 127;
            Wt[i] = (s <= t) ? P.gm_ws[(size_t)(g * 128 + t) * 128 + s] : 0.f;
            const float v = bf2f(VG[(R0 + t) * D + g * 128 + s]);
            Vt[i] = (v - mu[t]) * rs[t] * P.ln_g[g * 128 + s] + P.ln_b[g * 128 + s]; }
        __syncthreads();
        const int c = tid & 127, tq = tid >> 7;
#pragma unroll 1
        for (int ib = 0; ib < 4; ++ib) {
            float a[8];
#pragma unroll
            for (int i = 0; i < 8; ++i) a[i] = 0.f;
            const int t0 = tq * 32 + ib * 8;
            for (int s = 0; s < 128; ++s) { const float v = Vt[s * 128 + c];
#pragma unroll
                for (int i = 0; i < 8; ++i) a[i] += Wt[(t0 + i) * 128 + s] * v; }
#pragma unroll
            for (int i = 0; i < 8; ++i) { const int t = t0 + i; const size_t ad = (R0 + t) * 2048 + g * 128 + c;
                const float uu = bf2f(AB[ad]); AB[ad] = (bf16)f2bf(uu * (a[i] + P.gm_bs[g * 128 + t])); }
        }
        __syncthreads();
    }
}
__device__ __forceinline__ void attn_unit_valu(const Ptrs& P, unsigned char* lds, int un, int tid) {
    float* Kt = (float*)lds; float* Vt = (float*)(lds + 65536);
    bf16* AB = (bf16*)(P.ws + WS_AB); const bf16* KB = (const bf16*)(P.ws + WS_KB); const bf16* VB = (const bf16*)(P.ws + WS_VB);
    const int chunk = un & 31; const long R0 = (long)un * CHUNK;
    for (int g = 0; g < NKVH; ++g) {
        for (int i = tid; i < 16384; i += 512) { const int j = i >> 6, d = i & 63; const bool ok = (chunk > 0) || (j >= 128);
            const long kr = R0 - 128 + j;
            Kt[i] = ok ? bf2f(KB[kr * 256 + g * 64 + d]) : 0.f; Vt[i] = ok ? bf2f(VB[kr * 256 + g * 64 + d]) : 0.f; }
        __syncthreads();
        const int i = tid & 127, r = tid >> 7, h = g * 4 + r;
        bf16* qp = AB + (size_t)(R0 + i) * 2048 + 1024 + h * 64;
        unsigned qw[32]; float o[64];
#pragma unroll
        for (int d = 0; d < 32; ++d) qw[d] = ((const unsigned*)qp)[d];
#pragma unroll
        for (int d = 0; d < 64; ++d) o[d] = 0.f;
        float m = P.sinks[h] * LOG2E, l = 1.0f;
        const int i0 = i & ~63; const int jlo = i0 + 1, jhi = (i0 + 191 < 255) ? i0 + 191 : 255;
        for (int j = jlo; j <= jhi; ++j) {
            float s = 0.f;
#pragma unroll
            for (int d = 0; d < 32; ++d) s += pg8::bf_lo(qw[d]) * Kt[j * 64 + 2 * d] + pg8::bf_hi(qw[d]) * Kt[j * 64 + 2 * d + 1];
            const bool valid = (j > i) && (j <= i + 128) && (chunk > 0 || j >= 128);
            if (valid) { const float mn = fmaxf(m, s), sc = __builtin_amdgcn_exp2f(m - mn), p = __builtin_amdgcn_exp2f(s - mn); l = l * sc + p; m = mn;
#pragma unroll
                for (int d = 0; d < 64; ++d) o[d] = o[d] * sc + p * Vt[j * 64 + d]; }
        }
        const float il = 1.0f / l;
#pragma unroll
        for (int d = 0; d < 64; ++d) qp[d] = (bf16)f2bf(o[d] * il);
        __syncthreads();
    }
}

namespace mix {
typedef float f32x16 __attribute__((ext_vector_type(16)));
typedef short s16x4 __attribute__((ext_vector_type(4)));
typedef short v4i16_t __attribute__((ext_vector_type(4)));
typedef float f32x2_t __attribute__((ext_vector_type(2)));
typedef __bf16 bf16x2_t __attribute__((ext_vector_type(2)));
typedef unsigned u32x2 __attribute__((ext_vector_type(2)));
#define MFMA32(a, b, c) __builtin_amdgcn_mfma_f32_32x32x16_bf16((a), (b), (c), 0, 0, 0)
__device__ __forceinline__ unsigned cvtpk(float lo, float hi) { f32x2_t v = {lo, hi}; bf16x2_t b = __builtin_convertvector(v, bf16x2_t); return __builtin_bit_cast(unsigned, b); }
__device__ __forceinline__ int crow(int r, int h) { return (r & 3) + 8 * (r >> 2) + 4 * h; }
__device__ __forceinline__ unsigned off64(unsigned row, unsigned ch) { return 1024u * (row >> 3) + 512u * (ch >> 2) + 64u * (row & 7) + 16u * ((ch & 3) ^ ((row >> 2) & 3)); }
__device__ __forceinline__ s16x4 vtr(const LAS unsigned char* p) { return __builtin_bit_cast(s16x4, __builtin_amdgcn_ds_read_tr16_b64_v4i16((LAS v4i16_t*)p)); }
__device__ __forceinline__ bf16x8 tr_frag(const LAS unsigned char* tile, int rowa, int rowb, int ct, int lane) {
    const int blk = (lane >> 4) & 1, q = (lane & 15) >> 2, p = lane & 3;
    const s16x4 lo = vtr(tile + off64(rowa + q, 4 * ct + 2 * blk + (p >> 1)) + 8 * (p & 1));
    const s16x4 hi = vtr(tile + off64(rowb + q, 4 * ct + 2 * blk + (p >> 1)) + 8 * (p & 1));
    return (bf16x8){lo[0], lo[1], lo[2], lo[3], hi[0], hi[1], hi[2], hi[3]};
}

__device__ __forceinline__ void gate_wave(const Ptrs& P, LAS unsigned char* tile, const LAS float* mu, const LAS float* rs, int un, int g, int chh, int lane) {
    const int r32 = lane & 31, h = lane >> 5;
    const size_t R0 = (size_t)un * CHUNK; const int cbase = g * 128 + chh * 64;
    const bf16* VG = (const bf16*)(P.ws + WS_VG); bf16* AB = (bf16*)(P.ws + WS_AB);
    {
        const int sr = lane >> 3, ch = lane & 7;
        const bf16* vsrc = VG + (R0 + sr) * D + cbase + ch * 8;
        const f32x4 g0 = *(const f32x4*)(P.ln_g + cbase + ch * 8), g1 = *(const f32x4*)(P.ln_g + cbase + ch * 8 + 4);
        const f32x4 b0 = *(const f32x4*)(P.ln_b + cbase + ch * 8), b1 = *(const f32x4*)(P.ln_b + cbase + ch * 8 + 4);
#pragma unroll 4
        for (int k = 0; k < 16; ++k) { const int s = 8 * k + sr; const v4u w = *(const v4u*)(vsrc + (size_t)k * 8 * D); const float m = mu[s], r = rs[s];
            f32x4 y0 = ((f32x4){pg8::bf_lo(w.x), pg8::bf_hi(w.x), pg8::bf_lo(w.y), pg8::bf_hi(w.y)} - m) * r * g0 + b0;
            f32x4 y1 = ((f32x4){pg8::bf_lo(w.z), pg8::bf_hi(w.z), pg8::bf_lo(w.w), pg8::bf_hi(w.w)} - m) * r * g1 + b1;
            v4u o; o.x = cvtpk(y0[0], y0[1]); o.y = cvtpk(y0[2], y0[3]); o.z = cvtpk(y1[0], y1[1]); o.w = cvtpk(y1[2], y1[3]);
            *(LAS v4u*)(tile + off64(s, ch)) = o; }
    }
#pragma unroll
    for (int tt = 0; tt < 4; ++tt) {
        f32x16 acc0 = {}, acc1 = {};
        const float* wrow = P.gm_ws + (size_t)(g * 128 + 32 * tt + r32) * 128 + 8 * h;
#pragma unroll
        for (int st = 0; st <= tt; ++st)
#pragma unroll
            for (int ks = 0; ks < 2; ++ks) {
                f32x4 w0 = *(const f32x4*)(wrow + 32 * st + 16 * ks), w1 = *(const f32x4*)(wrow + 32 * st + 16 * ks + 4);
                if (st == tt) {
#pragma unroll
                    for (int e = 0; e < 4; ++e) { if (16 * ks + 8 * h + e > r32) w0[e] = 0.f; if (16 * ks + 8 * h + 4 + e > r32) w1[e] = 0.f; } }
                v4u yw; yw.x = cvtpk(w0[0], w0[1]); yw.y = cvtpk(w0[2], w0[3]); yw.z = cvtpk(w1[0], w1[1]); yw.w = cvtpk(w1[2], w1[3]);
                const bf16x8 Y = __builtin_bit_cast(bf16x8, yw);
                const int sb = 32 * st + 16 * ks + 8 * h;
                const bf16x8 X0 = tr_frag(tile, sb, sb + 4, 0, lane), X1 = tr_frag(tile, sb, sb + 4, 1, lane);
                acc0 = MFMA32(X0, Y, acc0); acc1 = MFMA32(X1, Y, acc1);
            }
        const int t = 32 * tt + r32; const float bsv = P.gm_bs[g * 128 + t];
        bf16* urow = AB + (R0 + t) * 2048 + cbase + 4 * h;
#pragma unroll
        for (int ct = 0; ct < 2; ++ct)
#pragma unroll
            for (int q = 0; q < 4; ++q) { u32x2* up = (u32x2*)(urow + 32 * ct + 8 * q); const u32x2 uw = *up;
                const float a0 = ct ? acc1[4 * q] : acc0[4 * q], a1 = ct ? acc1[4 * q + 1] : acc0[4 * q + 1], a2 = ct ? acc1[4 * q + 2] : acc0[4 * q + 2], a3 = ct ? acc1[4 * q + 3] : acc0[4 * q + 3];
                u32x2 o; o.x = cvtpk(pg8::bf_lo(uw.x) * (a0 + bsv), pg8::bf_hi(uw.x) * (a1 + bsv)); o.y = cvtpk(pg8::bf_lo(uw.y) * (a2 + bsv), pg8::bf_hi(uw.y) * (a3 + bsv));
                *up = o; }
    }
}
__device__ __forceinline__ void gate_unit_mfma(const Ptrs& P, LAS unsigned char* L, int un, int tid, int lane, int wave) {
    LAS float* mu = (LAS float*)(L + XTRA_OFF); LAS float* rs = mu + 128;
    const float* stats = (const float*)(P.ws + WS_STATS);
    if (tid < 128) { float s1 = 0.f, s2 = 0.f; const float* sp = stats + ((size_t)un * CHUNK + tid) * 32;
#pragma unroll
        for (int p = 0; p < 16; ++p) { const f32x2_t v = *(const f32x2_t*)(sp + 2 * p); s1 += v.x; s2 += v.y; }
        const float mean = s1 * (1.0f / D), var = fmaxf(s2 * (1.0f / D) - mean * mean, 0.f); mu[tid] = mean; rs[tid] = 1.0f / sqrtf(var + EPS); }
    __syncthreads();
#pragma unroll 1
    for (int rd = 0; rd < 2; ++rd) gate_wave(P, L + wave * 16384, mu, rs, un, 4 * rd + (wave >> 1), wave & 1, lane);
    __syncthreads();
}
__device__ __forceinline__ void attn_unit_mfma(const Ptrs& P, LAS unsigned char* L, int un, int tid, int lane, int wave) {
    const int r32 = lane & 31, h = lane >> 5, nb = un & 31; const long R0 = (long)un * CHUNK;
    bf16* AB = (bf16*)(P.ws + WS_AB); const bf16* KB = (const bf16*)(P.ws + WS_KB); const bf16* VB = (const bf16*)(P.ws + WS_VB);
    v4u kreg[4], vreg[4];
#define ATT_LOAD(g_) do { _Pragma("unroll") for (int i_ = 0; i_ < 4; ++i_) { const int n_ = tid + 512 * i_, row_ = n_ >> 3, ch_ = n_ & 7; \
        if (nb > 0 || i_ >= 2) { const size_t o_ = (size_t)(R0 - 128 + row_) * 256 + (g_) * 64 + ch_ * 8; kreg[i_] = *(const v4u*)(KB + o_); vreg[i_] = *(const v4u*)(VB + o_); } \
        else { kreg[i_] = (v4u){0u, 0u, 0u, 0u}; vreg[i_] = (v4u){0u, 0u, 0u, 0u}; } } } while (0)
#define ATT_STORE(buf_) do { _Pragma("unroll") for (int i_ = 0; i_ < 4; ++i_) { const int n_ = tid + 512 * i_, row_ = n_ >> 3, ch_ = n_ & 7; \
        *(LAS v4u*)(L + (buf_) * 65536 + off64(row_, ch_)) = kreg[i_]; *(LAS v4u*)(L + (buf_) * 65536 + 32768 + off64(row_, ch_)) = vreg[i_]; } } while (0)
    ATT_LOAD(0); ATT_STORE(0); __syncthreads();
#pragma unroll 1
    for (int g = 0; g < NKVH; ++g) {
        if (g + 1 < NKVH) ATT_LOAD(g + 1);
        const LAS unsigned char* Kt = L + (g & 1) * 65536; const LAS unsigned char* Vt = Kt + 32768;
        const int head = g * 4 + (wave >> 1); const float sink2 = P.sinks[head] * LOG2E;
#pragma unroll 1
        for (int qq = 0; qq < 2; ++qq) {
            const int qi = 2 * (wave & 1) + qq;
            bf16* qrow = AB + (size_t)(R0 + 32 * qi + r32) * 2048 + 1024 + head * 64;
            bf16x8 qf[4];
#pragma unroll
            for (int ks = 0; ks < 4; ++ks) qf[ks] = *(const bf16x8*)(qrow + 16 * ks + 8 * h);
            f32x16 S[5];
#pragma unroll
            for (int t5 = 0; t5 < 5; ++t5) { const int kt = qi + t5; f32x16 a = {};
#pragma unroll
                for (int ks = 0; ks < 4; ++ks) { const bf16x8 kf = *(const LAS bf16x8*)(Kt + off64(32 * kt + r32, 2 * ks + h)); a = MFMA32(kf, qf[ks], a); }
                S[t5] = a; }
            const float NEG = -INFINITY;
#pragma unroll
            for (int r = 0; r < 16; ++r) { if (crow(r, h) <= r32) S[0][r] = NEG; if (crow(r, h) > r32) S[4][r] = NEG; }
            if (nb == 0) {
#pragma unroll
                for (int t5 = 0; t5 < 4; ++t5) if (qi + t5 < 4) {
#pragma unroll
                    for (int r = 0; r < 16; ++r) S[t5][r] = NEG; } }
            float mx = NEG;
#pragma unroll
            for (int t5 = 0; t5 < 5; ++t5)
#pragma unroll
                for (int r = 0; r < 16; ++r) mx = fmaxf(mx, S[t5][r]);
            mx = fmaxf(mx, __shfl_xor(mx, 32)); mx = fmaxf(mx, sink2);
            float ls = 0.f;
#pragma unroll
            for (int t5 = 0; t5 < 5; ++t5)
#pragma unroll
                for (int r = 0; r < 16; ++r) { const float p = __builtin_amdgcn_exp2f(S[t5][r] - mx); S[t5][r] = p; ls += p; }
            ls += __shfl_xor(ls, 32); ls += __builtin_amdgcn_exp2f(sink2 - mx);
            f32x16 O0 = {}, O1 = {};
#pragma unroll
            for (int t5 = 0; t5 < 5; ++t5) { const int kt = qi + t5;
#pragma unroll
                for (int s = 0; s < 2; ++s) {
                    v4u pw; pw.x = cvtpk(S[t5][8 * s], S[t5][8 * s + 1]); pw.y = cvtpk(S[t5][8 * s + 2], S[t5][8 * s + 3]); pw.z = cvtpk(S[t5][8 * s + 4], S[t5][8 * s + 5]); pw.w = cvtpk(S[t5][8 * s + 6], S[t5][8 * s + 7]);
                    const bf16x8 Pp = __builtin_bit_cast(bf16x8, pw);
                    const int ra = 32 * kt + 16 * s + 4 * h;
                    const bf16x8 V0 = tr_frag(Vt, ra, ra + 8, 0, lane), V1 = tr_frag(Vt, ra, ra + 8, 1, lane);
                    O0 = MFMA32(V0, Pp, O0); O1 = MFMA32(V1, Pp, O1); } }
            const float il = 1.0f / ls;
#pragma unroll
            for (int dt = 0; dt < 2; ++dt)
#pragma unroll
                for (int q = 0; q < 4; ++q) { const float a0 = (dt ? O1[4 * q] : O0[4 * q]) * il, a1 = (dt ? O1[4 * q + 1] : O0[4 * q + 1]) * il, a2 = (dt ? O1[4 * q + 2] : O0[4 * q + 2]) * il, a3 = (dt ? O1[4 * q + 3] : O0[4 * q + 3]) * il;
                    u32x2 o; o.x = cvtpk(a0, a1); o.y = cvtpk(a2, a3); *(u32x2*)(qrow + 32 * dt + 8 * q + 4 * h) = o; }
        }
        if (g + 1 < NKVH) ATT_STORE((g + 1) & 1);
        __syncthreads();
    }
#undef ATT_LOAD
#undef ATT_STORE
}
}

#ifndef GATE_MFMA
#define GATE_MFMA 1
#endif
#ifndef ATTN_MFMA
#define ATTN_MFMA 1
#endif
#ifndef PH_MASK
#define PH_MASK 0x3ff
#endif
struct Args { const float* in[19]; float* out; unsigned char* ws; };
typedef const __attribute__((address_space(4))) Args* KArgs;
__global__ void __launch_bounds__(NWAVES * 64, 2) fwd_kernel(Args args) {
    extern __shared__ __attribute__((aligned(16))) unsigned char lds[];
    LAS unsigned char* L = (LAS unsigned char*)lds;
    const int tid0 = threadIdx.x;
    const int G = gridDim.x, bx = blockIdx.x, vcu = (G % 8 == 0) ? (bx % 8) * (G / 8) + bx / 8 : bx;
    KArgs ka0_ = (KArgs)__builtin_amdgcn_kernarg_segment_ptr();
    gu32* ctl = (gu32*)(ka0_->ws + WS_CTL);
    for (int u = tid0; u < (LDS_BYTES - LDSCTL_OFF) / 4; u += NWAVES * 64) ((LAS unsigned*)(L + LDSCTL_OFF))[u] = 0u;
    __syncthreads();
    XcdBarrier bar = xcd_barrier_post((unsigned*)(ctl + CW_BAR), (volatile LAS unsigned*)(L + BARST_OFF));
    LAS float* gsL = (LAS float*)(L + 0); LAS float* shL = (LAS float*)(L + 4096);
#define PH_PTRS \
    int tid = threadIdx.x; asm volatile("" : "+v"(tid)); const int lane = tid & 63, wave = __builtin_amdgcn_readfirstlane(tid >> 6); (void)lane; (void)wave; \
    KArgs ka_ = (KArgs)__builtin_amdgcn_kernarg_segment_ptr(); asm volatile("" : "+s"(ka_)); \
    Ptrs P; P.x = ka_->in[0]; P.c = ka_->in[1]; P.w_ada = ka_->in[2]; P.b_ada = ka_->in[3]; P.g_mix = ka_->in[4]; P.w_in = ka_->in[5]; P.b_in = ka_->in[6]; P.ln_g = ka_->in[7]; P.ln_b = ka_->in[8]; \
    P.gm_ws = ka_->in[9]; P.gm_bs = ka_->in[10]; P.sinks = ka_->in[11]; P.w_a = ka_->in[12]; P.w_b = ka_->in[13]; P.w_out = ka_->in[14]; P.g_mlp = ka_->in[15]; P.w_up = ka_->in[16]; P.w_down = ka_->in[17]; \
    P.g_final = ka_->in[18]; P.out = ka_->out; P.ws = ka_->ws; unsigned char* ws = P.ws; (void)ws; \
    bf16* Win_t = (bf16*)(ws + WS_WIN); bf16* Wab_t = (bf16*)(ws + WS_WAB); bf16* Wout_t = (bf16*)(ws + WS_WOUT); bf16* Wup_t = (bf16*)(ws + WS_WUP); bf16* Wdn_t = (bf16*)(ws + WS_WDN); \
    bf16* H = (bf16*)(ws + WS_H); bf16* AB = (bf16*)(ws + WS_AB); bf16* VG = (bf16*)(ws + WS_VG); bf16* KB = (bf16*)(ws + WS_KB); bf16* VB = (bf16*)(ws + WS_VB); \
    bf16* SGA = (bf16*)(ws + WS_SGA); bf16* SGB = (bf16*)(ws + WS_SGB); bf16* MG = (bf16*)(ws + WS_VG); bf16* HB = (bf16*)(ws + WS_HB); \
    float* modp = (float*)(ws + WS_MODP); float* modf = (float*)(ws + WS_MODF); float* stats = (float*)(ws + WS_STATS); \
    (void)Win_t; (void)Wab_t; (void)Wout_t; (void)Wup_t; (void)Wdn_t; (void)H; (void)AB; (void)VG; (void)KB; (void)VB; (void)SGA; (void)SGB; (void)MG; (void)HB; (void)modp; (void)modf; (void)stats

#if (PH_MASK >> 0) & 1
    { PH_PTRS; p0_prologue(P, L, vcu, G, tid, lane, wave); }
#endif
    xcd_barrier(bar);

#if (PH_MASK >> 1) & 1
    {
        PH_PTRS;
        const int rows_per = M / G, row0 = vcu * rows_per, b = row0 / SEQ;
        for (int col = tid; col < D; col += NWAVES * 64) { float sh = P.b_ada[col], sc = P.b_ada[D + col];
            for (int kc = 0; kc < KCH; ++kc) { sh += modp[(size_t)(kc * BATCH + b) * NMOD + col]; sc += modp[(size_t)(kc * BATCH + b) * NMOD + D + col]; }
            gsL[col] = P.g_mix[col] * (1.0f + sc); shL[col] = sh; }
        const int per = BATCH * NMOD / G;
        for (int i = tid; i < per; i += NWAVES * 64) { const int idx = vcu * per + i, b2 = idx / NMOD, n = idx % NMOD; float v = P.b_ada[n];
            for (int kc = 0; kc < KCH; ++kc) v += modp[(size_t)(kc * BATCH + b2) * NMOD + n];
            modf[idx] = v; }
        __syncthreads();
        for (int r = wave; r < rows_per; r += NWAVES) norm_row<true, true>(P.x + (size_t)(row0 + r) * D, gsL, shL, H + (size_t)(row0 + r) * D, lane);
    }
#endif
    xcd_barrier(bar);

#if (PH_MASK >> 2) & 1
    {
        PH_PTRS;
        pg8::Gemm g{H, Win_t, D, D}; pg8::StaticOrder S; S.init(M, INW, D, D, G, bx);
        pg8::EpiIn E{P.b_in, AB, VG, KB, VB, SGA, SGB, stats, QSCALE};
        pg8::gemm_phase<pg8::EpiIn, pg8::StaticOrder, true, true>(L, g, S, E, tid);
    }
#endif
    xcd_barrier(bar);

#if (PH_MASK >> 3) & 1
    { PH_PTRS;
    for (int un = vcu; un < M / CHUNK; un += G) {
#if GATE_MFMA
        mix::gate_unit_mfma(P, L, un, tid, lane, wave);
#else
        gate_unit_valu(P, lds, un, tid);
#endif
#if ATTN_MFMA
        mix::attn_unit_mfma(P, L, un, tid, lane, wave);
#else
        attn_unit_valu(P, lds, un, tid);
#endif
    } }
#endif
    xcd_barrier(bar);

#if (PH_MASK >> 4) & 1
    {
        PH_PTRS;
        pg8::Gemm g{AB, Wab_t, 2 * D, D}; pg8::PairOrder S; S.init(M, D, D, 2 * D, G, bx);
        pg8::EpiMerge E{SGA, SGB, MG, (pg8::f32x4*)(ws + WS_H) + (size_t)bx * (32 * 512)};
        pg8::gemm_phase<pg8::EpiMerge, pg8::PairOrder, true, true>(L, g, S, E, tid);
    }
#endif
    xcd_barrier(bar);

#if (PH_MASK >> 5) & 1
    {
        PH_PTRS;
        pg8::Gemm g{MG, Wout_t, D, D}; pg8::StaticOrder S; S.init(M, D, D, D, G, bx);
        pg8::EpiRes E{P.x, P.out, modf + 2 * D};
        pg8::gemm_phase<pg8::EpiRes, pg8::StaticOrder, true, true>(L, g, S, E, tid);
    }
#endif
    xcd_barrier(bar);

#if (PH_MASK >> 6) & 1
    {
        PH_PTRS;
        const int rows_per = M / G, row0 = vcu * rows_per, b = row0 / SEQ;
        for (int col = tid; col < D; col += NWAVES * 64) { gsL[col] = P.g_mlp[col] * (1.0f + modf[(size_t)b * NMOD + 4 * D + col]); shL[col] = modf[(size_t)b * NMOD + 3 * D + col]; }
        __syncthreads();
        for (int r = wave; r < rows_per; r += NWAVES) norm_row<true, true>(P.out + (size_t)(row0 + r) * D, gsL, shL, H + (size_t)(row0 + r) * D, lane);
    }
#endif
    xcd_barrier(bar);

#if (PH_MASK >> 7) & 1
    {
        PH_PTRS;
        pg8::Gemm g{H, Wup_t, D, D}; pg8::StaticOrder S; S.init(M, FF, D, D, G, bx);
        pg8::EpiUp E{HB, FF};
        pg8::gemm_phase<pg8::EpiUp, pg8::StaticOrder, true, true>(L, g, S, E, tid);
    }
#endif
    xcd_barrier(bar);

#if (PH_MASK >> 8) & 1
    {
        PH_PTRS;
        pg8::Gemm g{HB, Wdn_t, FF, FF}; pg8::StaticOrder S; S.init(M, D, FF, FF, G, bx);
        pg8::EpiRes E{P.out, P.out, modf + 5 * D};
        pg8::gemm_phase<pg8::EpiRes, pg8::StaticOrder, true, true>(L, g, S, E, tid);
    }
#endif
    xcd_barrier(bar);

#if (PH_MASK >> 9) & 1
    {
        PH_PTRS;
        const int rows_per = M / G, row0 = vcu * rows_per;
        for (int col = tid; col < D; col += NWAVES * 64) gsL[col] = P.g_final[col];
        __syncthreads();
        for (int r = wave; r < rows_per; r += NWAVES) norm_row<false, false>(P.out + (size_t)(row0 + r) * D, gsL, shL, P.out + (size_t)(row0 + r) * D, lane);
    }
#endif
}

extern "C" void kernel_launch(void* const* d_in, const int* in_sizes, int n_in, void* d_out, int out_size, void* d_ws, size_t ws_size, hipStream_t stream) {
    static int grid = 0;
    if (grid == 0) {
        if (n_in != 19 || in_sizes[0] != M * D || out_size != M * D || ws_size < WS_END) { fprintf(stderr, "kernel_launch: unexpected shapes (n_in %d, in0 %d, out %d, ws %zu); nothing launched\n", n_in, n_in > 0 ? in_sizes[0] : -1, out_size, ws_size); grid = -1; return; }
        int dev = 0, cus = 0, per_cu = 0;
        if (hipGetDevice(&dev) != hipSuccess || hipDeviceGetAttribute(&cus, hipDeviceAttributeMultiprocessorCount, dev) != hipSuccess) { fprintf(stderr, "kernel_launch: device query failed\n"); grid = -1; return; }
        if (hipFuncSetAttribute((const void*)fwd_kernel, hipFuncAttributeMaxDynamicSharedMemorySize, LDS_BYTES) != hipSuccess) { fprintf(stderr, "kernel_launch: hipFuncSetAttribute failed\n"); grid = -1; return; }
        if (hipOccupancyMaxActiveBlocksPerMultiprocessor(&per_cu, (const void*)fwd_kernel, NWAVES * 64, LDS_BYTES) != hipSuccess || per_cu < 1) { fprintf(stderr, "kernel_launch: occupancy query reports %d workgroups per CU; nothing launched\n", per_cu); (void)hipGetLastError(); grid = -1; return; }
        grid = cus;
        if (grid != 256) { fprintf(stderr, "kernel_launch: %d CUs, built for 256; nothing launched\n", grid); grid = -1; return; }
    }
    if (grid < 0) return;
    if (hipMemsetAsync((char*)d_ws + WS_CTL, 0, CTL_ZERO_BYTES, stream) != hipSuccess) { fprintf(stderr, "kernel_launch: hipMemsetAsync failed\n"); return; }
    Args a{};
    for (int i = 0; i < 19; ++i) a.in[i] = (const float*)d_in[i];
    a.out = (float*)d_out; a.ws = (unsigned char*)d_ws;
    hipLaunchKernelGGL(fwd_kernel, dim3(grid), dim3(NWAVES * 64), LDS_BYTES, stream, a);
}
```
